# Optimizing an MI355X kernel written in HIP

```python
import math
import jax, jax.numpy as jnp
from jax import lax
import numpy as np

D_MODEL = 2048
BATCH = 8
SEQ = 2048
DEPTH = 2

N_SUBLAYERS = 3
FFN_DIM = 5632
FFN_RES_WEIGHT = 0.5
MIXER_RES_WEIGHT = 1.0
NORM_EPS = 1e-6

SSD_HEADS = 32
SSD_HEAD_DIM = 64
SSD_WIDTH = SSD_HEADS * SSD_HEAD_DIM
SSD_GROUPS = 4
SSD_STATE = 128
SSD_CONV = 4
SSD_CHUNK = 128
SSD_BC_WIDTH = SSD_GROUPS * SSD_STATE
SSD_CONV_CH = SSD_WIDTH + 2 * SSD_BC_WIDTH

ATT_HEADS = 16
ATT_HEAD_DIM = 128
ATT_WIDTH = ATT_HEADS * ATT_HEAD_DIM
DILATED_PATTERNS = ((128, 1), (512, 4), (2048, 16))
ATT_BLOCK = 128
ROPE_THETA = 10000.0

HYB_SPLIT_SIZES = (SSD_WIDTH, SSD_CONV_CH, SSD_HEADS, ATT_WIDTH, ATT_WIDTH, ATT_WIDTH)
HYB_IN_WIDTH = SSD_WIDTH + SSD_CONV_CH + SSD_HEADS + 3 * ATT_WIDTH
HYB_OUT_WIDTH = SSD_WIDTH + ATT_WIDTH

SGU_WIDTH = 4096
SGU_GROUPS = 8
SGU_CHUNK = 128

N_HYB_LAYERS = (DEPTH + 1) // 2
N_SGU_LAYERS = DEPTH // 2

kernel_name = "hybrid_ssd_dilated_attn_sgu_macaron_trunk"


def rms_norm(x, g):
    x32 = x.astype(jnp.float32)
    y = x32 * lax.rsqrt(jnp.mean(x32 * x32, axis=-1, keepdims=True) + NORM_EPS)
    return (y * g.astype(jnp.float32)).astype(x.dtype)


def layer_norm(x, g, b):
    x32 = x.astype(jnp.float32)
    mu = jnp.mean(x32, axis=-1, keepdims=True)
    var = jnp.mean(jnp.square(x32 - mu), axis=-1, keepdims=True)
    y = (x32 - mu) * lax.rsqrt(var + NORM_EPS)
    return (y * g.astype(jnp.float32) + b.astype(jnp.float32)).astype(x.dtype)


def swiglu_ffn(h, w_gate, w_up, w_down):
    return (jax.nn.silu(h @ w_gate) * (h @ w_up)) @ w_down


def modulated_sublayer(x, mod, g_pre, g_post, res_weight, fn):
    shift, scale, gate = mod[:, 0, None, :], mod[:, 1, None, :], mod[:, 2, None, :]
    h = rms_norm(x, g_pre) * (1 + scale) + shift
    return x + res_weight * (1 + gate) * rms_norm(fn(h), g_post)


def apply_rope(t, positions):
    half = t.shape[-1] // 2
    inv_freq = ROPE_THETA ** (-jnp.arange(half, dtype=jnp.float32) / half)
    ang = positions.astype(jnp.float32)[..., None] * inv_freq
    cos = jnp.cos(ang)[:, :, None, :]
    sin = jnp.sin(ang)[:, :, None, :]
    t32 = t.astype(jnp.float32)
    t1, t2 = t32[..., :half], t32[..., half:]
    return jnp.concatenate([t1 * cos - t2 * sin, t2 * cos + t1 * sin], axis=-1).astype(t.dtype)


def causal_depthwise_conv(x, w, b):
    k = w.shape[0]
    out = lax.conv_general_dilated(
        x, w[:, None, :], window_strides=(1,), padding=((k - 1, 0),),
        dimension_numbers=("NWC", "WIO", "NWC"), feature_group_count=x.shape[-1])
    return out + b


def ssd_chunked_scan(x, dt, a, bmat, cmat):
    b, s, h, p = x.shape
    g, n = bmat.shape[2], bmat.shape[3]
    k = h // g
    cl = min(SSD_CHUNK, s)
    nc = s // cl
    xc = (x * dt[..., None]).reshape(b, nc, cl, g, k, p)
    adt = (a * dt).reshape(b, nc, cl, g, k).transpose(0, 3, 4, 1, 2)
    bc = bmat.reshape(b, nc, cl, g, n)
    cc = cmat.reshape(b, nc, cl, g, n)
    acs = jnp.cumsum(adt, axis=-1)
    causal = jnp.tril(jnp.ones((cl, cl), dtype=bool))
    seg = acs[..., :, None] - acs[..., None, :]
    decay = jnp.exp(jnp.where(causal, seg, -jnp.inf))
    cb = jnp.einsum("bclgn,bcsgn->bcgls", cc, bc)
    y_diag = jnp.einsum("bcgls,bgkcls,bcsgkp->bclgkp", cb, decay, xc)
    state_decay = jnp.exp(acs[..., -1:] - acs)
    states = jnp.einsum("bclgn,bgkcl,bclgkp->bcgkpn", bc, state_decay, xc)
    chunk_decay = jnp.exp(acs[..., -1])

    def step(carry, inp):
        st, dec = inp
        return carry * dec[..., None, None] + st, carry

    h0 = jnp.zeros((b, g, k, p, n), dtype=jnp.float32)
    _, prev = lax.scan(step, h0, (states.transpose(1, 0, 2, 3, 4, 5), chunk_decay.transpose(3, 0, 1, 2)))
    prev = prev.transpose(1, 0, 2, 3, 4, 5)
    y_off = jnp.einsum("bclgn,bcgkpn,bgkcl->bclgkp", cc, prev, jnp.exp(acs))
    return (y_diag + y_off).reshape(b, s, h, p)


def dilated_window_attention(q, k, v, window, dilation):
    b, s, h, dh = q.shape
    sub_len = s // dilation
    span = window // dilation
    blk = min(ATT_BLOCK, sub_len)
    nb = sub_len // blk

    def to_blocks(t):
        t = t.reshape(b, sub_len, dilation, h, dh).transpose(0, 2, 3, 1, 4)
        return t.reshape(b, dilation, h, nb, blk, dh)

    def with_prev(t):
        tp = jnp.concatenate([jnp.zeros_like(t[:, :, :, :1]), t], axis=3)
        return jnp.concatenate([tp[:, :, :, :-1], tp[:, :, :, 1:]], axis=4)

    qb = to_blocks(q)
    kw = with_prev(to_blocks(k))
    vw = with_prev(to_blocks(v))
    scores = jnp.einsum("brhnqd,brhnkd->brhnqk", qb, kw,
                        preferred_element_type=jnp.float32) * (dh ** -0.5)
    q_idx = jnp.arange(blk)[:, None] + blk
    k_idx = jnp.arange(2 * blk)[None, :]
    dist = q_idx - k_idx
    k_pos = jnp.arange(nb)[:, None, None] * blk - blk + k_idx[None]
    mask = (dist >= 0)[None] & (dist <= span)[None] & (k_pos >= 0)
    scores = jnp.where(mask, scores, -jnp.inf)
    lse = jax.nn.logsumexp(scores, axis=-1)
    probs = jnp.exp(scores - lse[..., None])
    out = jnp.einsum("brhnqk,brhnkd->brhnqd", probs, vw.astype(jnp.float32))
    out = out.reshape(b, dilation, h, sub_len, dh).transpose(0, 3, 1, 2, 4).reshape(b, s, h, dh)
    lse = lse.reshape(b, dilation, h, sub_len).transpose(0, 3, 1, 2).reshape(b, s, h)
    return out, lse


def hybrid_ssd_attention(h, positions, w_in, conv_w, conv_b, dt_bias, a_log, d_skip, ssd_norm_g, w_out):
    b, s, _ = h.shape
    proj = h @ w_in
    split_at = [int(i) for i in np.cumsum(HYB_SPLIT_SIZES)[:-1]]
    z, xbc, dt_raw, q, k, v = jnp.split(proj, split_at, axis=-1)
    xbc = jax.nn.silu(causal_depthwise_conv(xbc, conv_w, conv_b)).astype(jnp.float32)
    xs = xbc[..., :SSD_WIDTH].reshape(b, s, SSD_HEADS, SSD_HEAD_DIM)
    bm = xbc[..., SSD_WIDTH:SSD_WIDTH + SSD_BC_WIDTH].reshape(b, s, SSD_GROUPS, SSD_STATE)
    cm = xbc[..., SSD_WIDTH + SSD_BC_WIDTH:].reshape(b, s, SSD_GROUPS, SSD_STATE)
    dt = jax.nn.softplus(dt_raw.astype(jnp.float32) + dt_bias.astype(jnp.float32))
    a = -jnp.exp(a_log.astype(jnp.float32))
    y = ssd_chunked_scan(xs, dt, a, bm, cm) + xs * d_skip.astype(jnp.float32)[:, None]
    y = y.reshape(b, s, SSD_WIDTH) * jax.nn.silu(z.astype(jnp.float32))
    y_a = rms_norm(y, ssd_norm_g).astype(h.dtype)
    q = apply_rope(q.reshape(b, s, ATT_HEADS, ATT_HEAD_DIM), positions)
    k = apply_rope(k.reshape(b, s, ATT_HEADS, ATT_HEAD_DIM), positions)
    v = v.reshape(b, s, ATT_HEADS, ATT_HEAD_DIM)
    outs, lses = [], []
    for window, dilation in DILATED_PATTERNS:
        o, l = dilated_window_attention(q, k, v, window, dilation)
        outs.append(o)
        lses.append(l)
    weights = jax.nn.softmax(jnp.stack(lses, axis=0), axis=0)
    y_b = jnp.sum(weights[..., None] * jnp.stack(outs, axis=0), axis=0)
    y_b = y_b.reshape(b, s, ATT_WIDTH).astype(h.dtype)
    return jnp.concatenate([y_a, y_b], axis=-1) @ w_out


def chunked_sgu_mixer(h, w_in, b_in, ln_g, ln_b, w_spatial, b_spatial, w_out):
    b, s, _ = h.shape
    zz = jax.nn.gelu(h @ w_in + b_in)
    u, v = zz[..., :SGU_WIDTH], zz[..., SGU_WIDTH:]
    v = layer_norm(v, ln_g, ln_b)
    nc = s // SGU_CHUNK
    vc = v.reshape(b, nc, SGU_CHUNK, SGU_GROUPS, SGU_WIDTH // SGU_GROUPS)
    causal = jnp.tril(jnp.ones((SGU_CHUNK, SGU_CHUNK), dtype=bool))
    ws = jnp.where(causal, w_spatial, 0)
    mixed = jnp.einsum("gts,bcsgd->bctgd", ws, vc) + b_spatial.T[None, None, :, :, None]
    return (u * mixed.reshape(b, s, SGU_WIDTH)) @ w_out


def setup_inputs(seed: int = 0) -> dict:
    key = jax.random.key(seed)
    ks = iter(jax.random.split(key, 32))
    f32 = jnp.float32
    nrm = lambda shape, scale: jax.random.normal(next(ks), shape, f32) * scale
    x = nrm((BATCH, SEQ, D_MODEL), 1.0)
    c = nrm((BATCH, D_MODEL), 1.0)
    offsets = jax.random.randint(next(ks), (BATCH, 1), 0, 4096, dtype=jnp.int32)
    positions = offsets + jnp.arange(SEQ, dtype=jnp.int32)[None, :]
    w_mod = nrm((DEPTH, D_MODEL, N_SUBLAYERS * 3 * D_MODEL), 0.1 * D_MODEL ** -0.5)
    b_mod = nrm((DEPTH, N_SUBLAYERS * 3 * D_MODEL), 0.02)
    norm_pre = 1.0 + nrm((DEPTH, N_SUBLAYERS, D_MODEL), 0.02)
    norm_post = 1.0 + nrm((DEPTH, N_SUBLAYERS, D_MODEL), 0.02)
    ffn_w_gate = nrm((DEPTH, 2, D_MODEL, FFN_DIM), D_MODEL ** -0.5)
    ffn_w_up = nrm((DEPTH, 2, D_MODEL, FFN_DIM), D_MODEL ** -0.5)
    ffn_w_down = nrm((DEPTH, 2, FFN_DIM, D_MODEL), FFN_DIM ** -0.5)
    hyb_w_in = nrm((N_HYB_LAYERS, D_MODEL, HYB_IN_WIDTH), D_MODEL ** -0.5)
    hyb_conv_w = nrm((N_HYB_LAYERS, SSD_CONV, SSD_CONV_CH), SSD_CONV ** -0.5)
    hyb_conv_b = nrm((N_HYB_LAYERS, SSD_CONV_CH), 0.02)
    dt0 = jnp.exp(jax.random.uniform(next(ks), (N_HYB_LAYERS, SSD_HEADS), f32,
                                     minval=math.log(1e-3), maxval=math.log(1e-1)))
    hyb_dt_bias = dt0 + jnp.log(-jnp.expm1(-dt0))
    hyb_a_log = jnp.log(jax.random.uniform(next(ks), (N_HYB_LAYERS, SSD_HEADS), f32, minval=1.0, maxval=16.0))
    hyb_d_skip = 1.0 + nrm((N_HYB_LAYERS, SSD_HEADS), 0.1)
    hyb_norm_g = 1.0 + nrm((N_HYB_LAYERS, SSD_WIDTH), 0.02)
    hyb_w_out = nrm((N_HYB_LAYERS, HYB_OUT_WIDTH, D_MODEL), HYB_OUT_WIDTH ** -0.5)
    sgu_w_in = nrm((N_SGU_LAYERS, D_MODEL, 2 * SGU_WIDTH), D_MODEL ** -0.5)
    sgu_b_in = nrm((N_SGU_LAYERS, 2 * SGU_WIDTH), 0.02)
    sgu_ln_g = 1.0 + nrm((N_SGU_LAYERS, SGU_WIDTH), 0.02)
    sgu_ln_b = nrm((N_SGU_LAYERS, SGU_WIDTH), 0.02)
    sgu_w_spatial = nrm((N_SGU_LAYERS, SGU_GROUPS, SGU_CHUNK, SGU_CHUNK), SGU_CHUNK ** -0.5)
    sgu_b_spatial = 1.0 + nrm((N_SGU_LAYERS, SGU_GROUPS, SGU_CHUNK), 0.02)
    sgu_w_out = nrm((N_SGU_LAYERS, SGU_WIDTH, D_MODEL), SGU_WIDTH ** -0.5)
    return {"x": x, "c": c, "positions": positions, "w_mod": w_mod, "b_mod": b_mod,
            "norm_pre": norm_pre, "norm_post": norm_post,
            "ffn_w_gate": ffn_w_gate, "ffn_w_up": ffn_w_up, "ffn_w_down": ffn_w_down,
            "hyb_w_in": hyb_w_in, "hyb_conv_w": hyb_conv_w, "hyb_conv_b": hyb_conv_b,
            "hyb_dt_bias": hyb_dt_bias, "hyb_a_log": hyb_a_log, "hyb_d_skip": hyb_d_skip,
            "hyb_norm_g": hyb_norm_g, "hyb_w_out": hyb_w_out,
            "sgu_w_in": sgu_w_in, "sgu_b_in": sgu_b_in, "sgu_ln_g": sgu_ln_g, "sgu_ln_b": sgu_ln_b,
            "sgu_w_spatial": sgu_w_spatial, "sgu_b_spatial": sgu_b_spatial, "sgu_w_out": sgu_w_out}


def reference(x, c, positions, w_mod, b_mod, norm_pre, norm_post, ffn_w_gate, ffn_w_up, ffn_w_down,
              hyb_w_in, hyb_conv_w, hyb_conv_b, hyb_dt_bias, hyb_a_log, hyb_d_skip, hyb_norm_g, hyb_w_out,
              sgu_w_in, sgu_b_in, sgu_ln_g, sgu_ln_b, sgu_w_spatial, sgu_b_spatial, sgu_w_out):
    c_act = jax.nn.silu(c)
    for layer in range(DEPTH):
        mod = (c_act @ w_mod[layer] + b_mod[layer]).reshape(-1, N_SUBLAYERS, 3, D_MODEL)
        x = modulated_sublayer(
            x, mod[:, 0], norm_pre[layer, 0], norm_post[layer, 0], FFN_RES_WEIGHT,
            lambda h: swiglu_ffn(h, ffn_w_gate[layer, 0], ffn_w_up[layer, 0], ffn_w_down[layer, 0]))
        i = layer // 2
        if layer % 2 == 0:
            mixer = lambda h: hybrid_ssd_attention(
                h, positions, hyb_w_in[i], hyb_conv_w[i], hyb_conv_b[i], hyb_dt_bias[i],
                hyb_a_log[i], hyb_d_skip[i], hyb_norm_g[i], hyb_w_out[i])
        else:
            mixer = lambda h: chunked_sgu_mixer(
                h, sgu_w_in[i], sgu_b_in[i], sgu_ln_g[i], sgu_ln_b[i],
                sgu_w_spatial[i], sgu_b_spatial[i], sgu_w_out[i])
        x = modulated_sublayer(x, mod[:, 1], norm_pre[layer, 1], norm_post[layer, 1], MIXER_RES_WEIGHT, mixer)
        x = modulated_sublayer(
            x, mod[:, 2], norm_pre[layer, 2], norm_post[layer, 2], FFN_RES_WEIGHT,
            lambda h: swiglu_ffn(h, ffn_w_gate[layer, 1], ffn_w_up[layer, 1], ffn_w_down[layer, 1]))
    return x
```

```cpp
#include <hip/hip_runtime.h>
#include <cstdio>
#include <cstdint>
#ifndef MK_N_LAUNCHES
#define MK_N_LAUNCHES 1
#endif
namespace pg8 {
#define PG8_LAS __attribute__((address_space(3)))
typedef unsigned short bf16_t;
typedef short bf16x8 __attribute__((ext_vector_type(8)));
typedef float f32x4 __attribute__((ext_vector_type(4)));
typedef unsigned u32x4 __attribute__((ext_vector_type(4)));
constexpr int BM = 256, BK = 64, HALF = 128, HTB = HALF * BK * 2  , STAGE_BYTES = 8 * HTB, NXCD = 8, WGM = 8;

__host__ __device__ __forceinline__ int lds_byte(int r, int c) { const int st = (r >> 4) * 2 + (c >> 5), rr = r & 15, cc = c & 31, ob = rr * 64 + cc * 2; return st * 1024 + (ob ^ (((ob >> 9) & 1) << 5)); }
__host__ __device__ __forceinline__ void stage_rc(int b, int& R, int& C) { const int st = b / 1024, sb = b % 1024, swz = sb ^ (((sb >> 9) & 1) << 5); R = (st >> 1) * 16 + swz / 64; C = (st & 1) * 32 + (swz % 64) / 2; }
__host__ __device__ __forceinline__ int perm32(int rho) { const int n = rho >> 4, i = rho & 15; return 8 * (i >> 2) + 4 * n + (i & 3); }

struct Unit { int pm, pn; };
struct Gemm { const bf16_t* A; const bf16_t* Bt; int M, N, K; };

struct StaticOrder {
    int nM, nN, nwg, G, c;
    __host__ __device__ void init(int M, int N, int G_, int c_) { nM = M / BM; nN = N / BM; nwg = nM * nN; G = G_; c = c_; }
    __host__ __device__ bool next(int i, Unit& u) const {
        const long L = (long)i * G + c; if (L >= nwg) return false;
        int wgid = (int)L; { const int q = nwg / NXCD, r = nwg % NXCD, xcd = wgid % NXCD, off = wgid / NXCD; wgid = (xcd < r ? xcd * (q + 1) : r * (q + 1) + (xcd - r) * q) + off; }
        const int nig = WGM * nN, gid = wgid / nig, fm = gid * WGM, gsz = (nM - fm) < WGM ? (nM - fm) : WGM;
        u.pm = fm + ((wgid % nig) % gsz); u.pn = (wgid % nig) / gsz; return true;
    }
    __device__ __forceinline__ void a_ready(const Unit&) const {}
    __device__ __forceinline__ void done(const Unit&) const {}
};

__device__ __forceinline__ unsigned cvt_pk_bf16(float lo, float hi) { unsigned r; asm volatile("v_cvt_pk_bf16_f32 %0, %1, %2" : "=v"(r) : "v"(lo), "v"(hi)); return r; }
__device__ __forceinline__ float fast_silu(float x) { return x * __builtin_amdgcn_rcpf(1.0f + __builtin_amdgcn_exp2f(-1.4426950408889634f * x)); }
__device__ __forceinline__ float fast_gelu_tanh(float x) { const float u = x * (0.7978845608028654f + 0.035677408136300125f * x * x); return x * __builtin_amdgcn_rcpf(1.0f + __builtin_amdgcn_exp2f(-2.8853900817779268f * u)); }

typedef float f32x2 __attribute__((ext_vector_type(2)));
__device__ __forceinline__ f32x2 gelu_tanh_pk(f32x2 x) { const f32x2 xx = x * x; const f32x2 t = x * (xx * (-0.1029432395800235f) + (-2.302208198144325f));
    f32x2 e; e.x = __builtin_amdgcn_exp2f(t.x); e.y = __builtin_amdgcn_exp2f(t.y); const f32x2 d = e + 1.0f; f32x2 r; r.x = __builtin_amdgcn_rcpf(d.x); r.y = __builtin_amdgcn_rcpf(d.y); return x * r; }
__device__ __forceinline__ f32x2 swiglu_pk(f32x2 g, f32x2 u) { const f32x2 t = g * (-1.4426950408889634f); f32x2 e; e.x = __builtin_amdgcn_exp2f(t.x); e.y = __builtin_amdgcn_exp2f(t.y); const f32x2 d = e + 1.0f;
    f32x2 r; r.x = __builtin_amdgcn_rcpf(d.x); r.y = __builtin_amdgcn_rcpf(d.y); return (g * u) * r; }
struct EpiPlain {
    static constexpr bool PERM = true, AFTER_DRAIN = false, MIDHOOK = false; static constexpr int NST = 16;
    bf16_t* O; int ldc;
    __device__ __forceinline__ void operator()(const f32x4 (&acc)[2][2][4][2], const Unit& u, int wr, int wc, int fr, int fq) const {
        const int row0 = u.pm * BM + wr * 64 + fr, col0 = u.pn * BM + wc * 32 + 8 * fq;
#pragma unroll
        for (int ai = 0; ai < 2; ++ai)
#pragma unroll
            for (int m = 0; m < 4; ++m) { bf16_t* rowp = O + (size_t)(row0 + ai * HALF + m * 16) * ldc + col0;
#pragma unroll
                for (int bj = 0; bj < 2; ++bj) { const f32x4 v0 = acc[ai][bj][m][0], v1 = acc[ai][bj][m][1];
                    u32x4 w; w.x = cvt_pk_bf16(v0[0], v0[1]); w.y = cvt_pk_bf16(v0[2], v0[3]); w.z = cvt_pk_bf16(v1[0], v1[1]); w.w = cvt_pk_bf16(v1[2], v1[3]);
                    *(u32x4*)(rowp + bj * HALF) = w; } }
    }
};
struct EpiPlainMid {
    static constexpr bool PERM = true, AFTER_DRAIN = false, MIDHOOK = true; static constexpr int NST = 16;
    bf16_t* O; int ldc; const PG8_LAS float* rs;
    __device__ __forceinline__ void operator()(const f32x4 (&acc)[2][2][4][2], const Unit& u, int wr, int wc, int fr, int fq) const {
        const int row0 = u.pm * BM + wr * 64 + fr, col0 = u.pn * BM + wc * 32 + 8 * fq;
#pragma unroll
        for (int ai = 0; ai < 2; ++ai)
#pragma unroll
            for (int m = 0; m < 4; ++m) { bf16_t* rowp = O + (size_t)(row0 + ai * HALF + m * 16) * ldc + col0;
#pragma unroll
                for (int bj = 0; bj < 2; ++bj) { const f32x4 v0 = acc[ai][bj][m][0], v1 = acc[ai][bj][m][1];
                    u32x4 w; w.x = cvt_pk_bf16(v0[0], v0[1]); w.y = cvt_pk_bf16(v0[2], v0[3]); w.z = cvt_pk_bf16(v1[0], v1[1]); w.w = cvt_pk_bf16(v1[2], v1[3]);
                    *(u32x4*)(rowp + bj * HALF) = w; } }
    }
    __device__ __forceinline__ void mid(f32x4 (&acc)[2][2][4][2], int ui, int wr, int fr) const {
#pragma unroll
        for (int ai = 0; ai < 2; ++ai)
#pragma unroll
            for (int m = 0; m < 4; ++m) { const float r = rs[ui * BM + ai * HALF + wr * 64 + m * 16 + fr];
#pragma unroll
                for (int bj = 0; bj < 2; ++bj)
#pragma unroll
                    for (int n = 0; n < 2; ++n) acc[ai][bj][m][n] = acc[ai][bj][m][n] * r; }
    }
};
struct EpiSwiGLU {
    static constexpr bool PERM = true, AFTER_DRAIN = false, MIDHOOK = false; static constexpr int NST = 8;
    bf16_t* O; int ldc;
    __device__ __forceinline__ void operator()(const f32x4 (&acc)[2][2][4][2], const Unit& u, int wr, int wc, int fr, int fq) const {
        const int row0 = u.pm * BM + wr * 64 + fr, col0 = u.pn * HALF + wc * 32 + 8 * fq;
#pragma unroll
        for (int ai = 0; ai < 2; ++ai)
#pragma unroll
            for (int m = 0; m < 4; ++m) { bf16_t* rowp = O + (size_t)(row0 + ai * HALF + m * 16) * ldc + col0;
                const f32x4 g0 = acc[ai][0][m][0], g1 = acc[ai][0][m][1], u0 = acc[ai][1][m][0], u1 = acc[ai][1][m][1];
                const f32x2 ha = swiglu_pk((f32x2){g0[0], g0[1]}, (f32x2){u0[0], u0[1]}), hb = swiglu_pk((f32x2){g0[2], g0[3]}, (f32x2){u0[2], u0[3]}), hc = swiglu_pk((f32x2){g1[0], g1[1]}, (f32x2){u1[0], u1[1]}), hd = swiglu_pk((f32x2){g1[2], g1[3]}, (f32x2){u1[2], u1[3]});
                u32x4 w; w.x = cvt_pk_bf16(ha.x, ha.y); w.y = cvt_pk_bf16(hb.x, hb.y); w.z = cvt_pk_bf16(hc.x, hc.y); w.w = cvt_pk_bf16(hd.x, hd.y);
                *(u32x4*)(rowp) = w; }
    }
};
struct EpiGelu {
    static constexpr bool PERM = true, AFTER_DRAIN = false, MIDHOOK = false; static constexpr int NST = 16;
    bf16_t* O; int ldc; const float* bias; float* stats; int stat_tile0;
    __device__ __forceinline__ void operator()(const f32x4 (&acc)[2][2][4][2], const Unit& u, int wr, int wc, int fr, int fq) const {
        const int row0 = u.pm * BM + wr * 64 + fr, col0 = u.pn * BM + wc * 32 + 8 * fq;
        f32x4 bv[2][2];
#pragma unroll
        for (int bj = 0; bj < 2; ++bj)
#pragma unroll
            for (int n = 0; n < 2; ++n) bv[bj][n] = *(const f32x4*)(bias + col0 + bj * HALF + 4 * n);
        const bool st = u.pn >= stat_tile0;
#pragma unroll
        for (int ai = 0; ai < 2; ++ai)
#pragma unroll
            for (int m = 0; m < 4; ++m) { const int r = row0 + ai * HALF + m * 16; bf16_t* rowp = O + (size_t)r * ldc + col0; f32x2 a1 = (f32x2){0.f, 0.f}, a2 = a1;
#pragma unroll
                for (int bj = 0; bj < 2; ++bj) { const f32x4 v0 = acc[ai][bj][m][0] + bv[bj][0], v1 = acc[ai][bj][m][1] + bv[bj][1];
                    const f32x2 g0 = gelu_tanh_pk((f32x2){v0[0], v0[1]}), g1 = gelu_tanh_pk((f32x2){v0[2], v0[3]}), g2 = gelu_tanh_pk((f32x2){v1[0], v1[1]}), g3 = gelu_tanh_pk((f32x2){v1[2], v1[3]});
                    a1 += (g0 + g1) + (g2 + g3); a2 += (g0 * g0 + g1 * g1) + (g2 * g2 + g3 * g3);
                    u32x4 w; w.x = cvt_pk_bf16(g0.x, g0.y); w.y = cvt_pk_bf16(g1.x, g1.y); w.z = cvt_pk_bf16(g2.x, g2.y); w.w = cvt_pk_bf16(g3.x, g3.y);
                    *(u32x4*)(rowp + bj * HALF) = w; }
                float s1 = a1.x + a1.y, s2 = a2.x + a2.y;
                if (st) { s1 += __shfl_xor(s1, 16); s1 += __shfl_xor(s1, 32); s2 += __shfl_xor(s2, 16); s2 += __shfl_xor(s2, 32);
                    if (fq == 0) { float* sp = stats + ((size_t)r * 64 + (u.pn - stat_tile0) * 4 + wc) * 2; sp[0] = s1; sp[1] = s2; } } }
    }
};
struct EpiHyb {
    static constexpr bool PERM = true, AFTER_DRAIN = false, MIDHOOK = false; static constexpr int NST = 16;
    unsigned char* big; const int* pos;
    float qscale;
    __device__ __forceinline__ void operator()(const f32x4 (&acc)[2][2][4][2], const Unit& u, int wr, int wc, int fr, int fq) const {
        const int row0 = u.pm * BM + wr * 64 + fr; const int pn = u.pn;
        if (pn < 20 || (pn >= 36 && pn < 44)) {
            const size_t boff = pn < 8 ? (size_t)0 : (pn < 20 ? ((size_t)363 << 20) : ((size_t)192 << 20)); const int ldc = (pn >= 8 && pn < 20) ? 3072 : 2048, ct = pn < 8 ? pn : (pn < 20 ? pn - 8 : pn - 36);
            bf16_t* base = (bf16_t*)(big + boff);
            const int col0 = ct * BM + wc * 32 + 8 * fq;
#pragma unroll
            for (int ai = 0; ai < 2; ++ai)
#pragma unroll
                for (int m = 0; m < 4; ++m) { bf16_t* rowp = base + (size_t)(row0 + ai * HALF + m * 16) * ldc + col0;
#pragma unroll
                    for (int bj = 0; bj < 2; ++bj) { const f32x4 v0 = acc[ai][bj][m][0], v1 = acc[ai][bj][m][1];
                        u32x4 w; w.x = cvt_pk_bf16(v0[0], v0[1]); w.y = cvt_pk_bf16(v0[2], v0[3]); w.z = cvt_pk_bf16(v1[0], v1[1]); w.w = cvt_pk_bf16(v1[2], v1[3]);
                        *(u32x4*)(rowp + bj * HALF) = w; } }
        } else if (pn < 36) {
            const bool isq = pn < 28; bf16_t* base = (bf16_t*)(big + (isq ? ((size_t)64 << 20) : ((size_t)128 << 20))); const int t = isq ? pn - 20 : pn - 28; const float sc = isq ? qscale : 1.0f;
            const int cp = wc * 32 + 8 * fq;
            const int head = 2 * t + (cp >> 6), jj = cp & 63;
            float fr8[8];
#pragma unroll
            for (int e = 0; e < 8; ++e) fr8[e] = exp2f(-(float)(jj + e) * (13.287712379549449f / 64.0f)) * 0.15915494309189535f;
            int pv[8];
#pragma unroll
            for (int ai = 0; ai < 2; ++ai)
#pragma unroll
                for (int m = 0; m < 4; ++m) pv[ai * 4 + m] = pos[row0 + ai * HALF + m * 16];
#pragma unroll
            for (int ai = 0; ai < 2; ++ai)
#pragma unroll
                for (int m = 0; m < 4; ++m) { const int r = row0 + ai * HALF + m * 16; const float pf = (float)pv[ai * 4 + m];
                    float cs[8], sn[8];
#pragma unroll
                    for (int e = 0; e < 8; ++e) { const float rev = __builtin_amdgcn_fractf(pf * fr8[e]); cs[e] = __builtin_amdgcn_cosf(rev); sn[e] = __builtin_amdgcn_sinf(rev); }
                    float o1[8], o2[8];
#pragma unroll
                    for (int n = 0; n < 2; ++n)
#pragma unroll
                        for (int j = 0; j < 4; ++j) { const float t1 = acc[ai][0][m][n][j], t2 = acc[ai][1][m][n][j]; const int e = 4 * n + j;
                            o1[e] = (t1 * cs[e] - t2 * sn[e]) * sc; o2[e] = (t2 * cs[e] + t1 * sn[e]) * sc; }
                    bf16_t* rowp = base + (size_t)r * 2048 + head * 128 + jj;
                    u32x4 w; w.x = cvt_pk_bf16(o1[0], o1[1]); w.y = cvt_pk_bf16(o1[2], o1[3]); w.z = cvt_pk_bf16(o1[4], o1[5]); w.w = cvt_pk_bf16(o1[6], o1[7]);
                    *(u32x4*)(rowp) = w;
                    w.x = cvt_pk_bf16(o2[0], o2[1]); w.y = cvt_pk_bf16(o2[2], o2[3]); w.z = cvt_pk_bf16(o2[4], o2[5]); w.w = cvt_pk_bf16(o2[6], o2[7]);
                    *(u32x4*)(rowp + 64) = w; }
        }
    }
};
template <class Epi, class Sched, bool ALIGN_EPI = false, bool SP2 = false>
__device__ __forceinline__ void gemm_phase(PG8_LAS unsigned char* lds, const Gemm g, const Sched& S, const Epi& E) {
    const int tid = threadIdx.x, wid = __builtin_amdgcn_readfirstlane(tid >> 6), lane = tid & 63, wr = wid >> 2, wc = wid & 3, fr = lane & 15, fq = lane >> 4;
    const int K = g.K, nt = K / BK;
    unsigned voffA[2], voffB[2];
#pragma unroll
    for (int i = 0; i < 2; ++i) { int R, C; stage_rc(tid * 16 + i * 8192, R, C); const int Rb = Epi::PERM ? ((R & ~31) + perm32(R & 31)) : R;
        voffA[i] = (unsigned)(R * K + C) * 2u; voffB[i] = (unsigned)(Rb * K + C) * 2u; }
    const size_t kstep = (size_t)(BK * 2);
    const size_t hstep = (size_t)HALF * K * 2;
    const size_t tstep = 2 * hstep;
    const unsigned ldsw = (unsigned)wid * 1024u;
    const int aoff = lds_byte(wr * 64 + fr, fq * 8), boff = lds_byte(wc * 32 + fr, fq * 8);
#define PG8_SA(b, h) (((b) * 2 + (h)) * HTB)
#define PG8_SB(b, h) ((4 + (b) * 2 + (h)) * HTB)
#define PG8_STAGE(bufoff, gbase, voff) do { _Pragma("unroll") for (int _i = 0; _i < 2; ++_i) \
        __builtin_amdgcn_global_load_lds((const unsigned*)((const char*)(gbase) + (voff)[_i]), (PG8_LAS unsigned*)(lds + (bufoff) + ldsw + _i * 8192), 16, 0, 0); } while (0)
#define PG8_LDA(dst, b, h) do { _Pragma("unroll") for (int m = 0; m < 4; ++m) _Pragma("unroll") for (int k = 0; k < 2; ++k) dst[m][k] = *(const PG8_LAS bf16x8*)(lds + PG8_SA(b, h) + aoff + m * 2048 + k * 1024); } while (0)
#define PG8_LDB(dst, b, h) do { _Pragma("unroll") for (int n = 0; n < 2; ++n) _Pragma("unroll") for (int k = 0; k < 2; ++k) dst[n][k] = *(const PG8_LAS bf16x8*)(lds + PG8_SB(b, h) + boff + n * 2048 + k * 1024); } while (0)
#define PG8_MMA(ai, bj, At, Bt) do { __builtin_amdgcn_s_setprio(1); _Pragma("unroll") for (int m = 0; m < 4; ++m) _Pragma("unroll") for (int n = 0; n < 2; ++n) _Pragma("unroll") for (int k = 0; k < 2; ++k) \
        acc[ai][bj][m][n] = __builtin_amdgcn_mfma_f32_16x16x32_bf16(Bt[n][k], At[m][k], acc[ai][bj][m][n], 0, 0, 0); __builtin_amdgcn_s_setprio(0); } while (0)
#define PG8_WAIT_V(n) asm volatile("s_waitcnt vmcnt(" #n ")" ::: "memory")
#define PG8_WAIT_L(n) asm volatile("s_waitcnt lgkmcnt(" #n ")" ::: "memory")
#define PG8_BAR __builtin_amdgcn_s_barrier()
#define PG8_SCHED __builtin_amdgcn_sched_barrier(0)
    Unit cur, nxt; int ui = 0;
    if (!S.next(0, cur)) return;
    f32x4 acc[2][2][4][2];
#pragma unroll
    for (int a = 0; a < 2; ++a)
#pragma unroll
        for (int b = 0; b < 2; ++b)
#pragma unroll
            for (int m = 0; m < 4; ++m)
#pragma unroll
                for (int n = 0; n < 2; ++n) acc[a][b][m][n] = (f32x4){0.f, 0.f, 0.f, 0.f};
    bf16x8 At[4][2], B0[2][2], B1[2][2];
    const char* cA = (const char*)g.A + (size_t)cur.pm * tstep; const char* cB = (const char*)g.Bt + (size_t)cur.pn * tstep;
    S.a_ready(cur);
    if constexpr (SP2) {
        PG8_STAGE(PG8_SB(0, 0), cB, voffB); PG8_STAGE(PG8_SB(0, 1), cB + hstep, voffB); PG8_STAGE(PG8_SA(0, 0), cA, voffA); PG8_STAGE(PG8_SA(0, 1), cA + hstep, voffA);
        if (wr == 1) PG8_BAR;
        PG8_WAIT_V(2); PG8_BAR;
        PG8_STAGE(PG8_SB(1, 0), cB + kstep, voffB); PG8_STAGE(PG8_SA(1, 0), cA + kstep, voffA); PG8_STAGE(PG8_SB(1, 1), cB + hstep + kstep, voffB);
        PG8_WAIT_V(6); PG8_BAR;
    } else {
        PG8_STAGE(PG8_SB(0, 0), cB, voffB); PG8_STAGE(PG8_SA(0, 0), cA, voffA); PG8_STAGE(PG8_SB(0, 1), cB + hstep, voffB); PG8_STAGE(PG8_SA(0, 1), cA + hstep, voffA);
        if (wr == 1) PG8_BAR;
        PG8_WAIT_V(4); PG8_BAR;
        PG8_STAGE(PG8_SB(1, 0), cB + kstep, voffB); PG8_STAGE(PG8_SA(1, 0), cA + kstep, voffA); PG8_STAGE(PG8_SB(1, 1), cB + hstep + kstep, voffB);
        PG8_WAIT_V(6); PG8_BAR;
    }
    for (;;) {
        const bool has_next = S.next(ui + 1, nxt);
        const char* nA = has_next ? (const char*)g.A + (size_t)nxt.pm * tstep : cA; const char* nB = has_next ? (const char*)g.Bt + (size_t)nxt.pn * tstep : cB;
        for (int t = 0; t < nt; t += 2) {
            const bool last = (t == nt - 2);
            const char* a1 = cA + (size_t)(t + 1) * kstep;
            const char* a2 = last ? nA : cA + (size_t)(t + 2) * kstep; const char* b2 = last ? nB : cB + (size_t)(t + 2) * kstep;
            const char* a3 = a2 + kstep; const char* b3 = b2 + kstep;
            if constexpr (Epi::MIDHOOK) { if (t == (nt >> 1)) E.mid(acc, ui, wr, fr); }
            if (last && has_next) S.a_ready(nxt);
            if constexpr (SP2) {
            PG8_LDB(B0, 0, 0); PG8_LDB(B1, 0, 1); PG8_SCHED; PG8_LDA(At, 0, 0); PG8_STAGE(PG8_SA(1, 1), a1 + hstep, voffA);
            PG8_WAIT_V(8); PG8_WAIT_L(0); PG8_BAR; PG8_MMA(0, 0, At, B0); PG8_MMA(0, 1, At, B1); PG8_BAR; PG8_SCHED;
            PG8_LDA(At, 0, 1); PG8_STAGE(PG8_SB(0, 0), b2, voffB); PG8_STAGE(PG8_SB(0, 1), b2 + hstep, voffB); PG8_STAGE(PG8_SA(0, 0), a2, voffA);
            PG8_WAIT_V(8); PG8_WAIT_L(0); PG8_BAR; PG8_MMA(1, 0, At, B0); PG8_MMA(1, 1, At, B1); PG8_BAR; PG8_SCHED;
            PG8_LDB(B0, 1, 0); PG8_LDB(B1, 1, 1); PG8_SCHED; PG8_LDA(At, 1, 0); PG8_STAGE(PG8_SA(0, 1), a2 + hstep, voffA);
            PG8_WAIT_V(8); PG8_WAIT_L(0); PG8_BAR; PG8_MMA(0, 0, At, B0); PG8_MMA(0, 1, At, B1); PG8_BAR; PG8_SCHED;
            PG8_LDA(At, 1, 1); PG8_STAGE(PG8_SB(1, 0), b3, voffB); PG8_STAGE(PG8_SB(1, 1), b3 + hstep, voffB); PG8_STAGE(PG8_SA(1, 0), a3, voffA);
            PG8_WAIT_V(8); PG8_WAIT_L(0); PG8_BAR; PG8_MMA(1, 0, At, B0); PG8_MMA(1, 1, At, B1); PG8_BAR; PG8_SCHED;
            } else {
            PG8_LDB(B0, 0, 0); PG8_SCHED; PG8_LDA(At, 0, 0); PG8_STAGE(PG8_SA(1, 1), a1 + hstep, voffA);
            PG8_WAIT_L(8); PG8_BAR; PG8_WAIT_L(0); PG8_MMA(0, 0, At, B0); PG8_BAR; PG8_SCHED;
            PG8_LDB(B1, 0, 1); PG8_STAGE(PG8_SB(0, 0), b2, voffB);
            PG8_BAR; PG8_WAIT_L(0); PG8_MMA(0, 1, At, B1); PG8_BAR;
            PG8_LDA(At, 0, 1); PG8_STAGE(PG8_SA(0, 0), a2, voffA);
            PG8_BAR; PG8_WAIT_L(0); PG8_MMA(1, 0, At, B0); PG8_BAR; PG8_SCHED;
            PG8_STAGE(PG8_SB(0, 1), b2 + hstep, voffB);
            PG8_WAIT_V(6); PG8_BAR; PG8_MMA(1, 1, At, B1); PG8_BAR;
            PG8_LDB(B0, 1, 0); PG8_SCHED; PG8_LDA(At, 1, 0); PG8_STAGE(PG8_SA(0, 1), a2 + hstep, voffA);
            PG8_WAIT_L(8); PG8_BAR; PG8_WAIT_L(0); PG8_MMA(0, 0, At, B0); PG8_BAR; PG8_SCHED;
            PG8_LDB(B1, 1, 1); PG8_STAGE(PG8_SB(1, 0), b3, voffB);
            PG8_BAR; PG8_WAIT_L(0); PG8_MMA(0, 1, At, B1); PG8_BAR;
            PG8_LDA(At, 1, 1); PG8_STAGE(PG8_SA(1, 0), a3, voffA);
            PG8_BAR; PG8_WAIT_L(0); PG8_MMA(1, 0, At, B0); PG8_BAR; PG8_SCHED;
            PG8_STAGE(PG8_SB(1, 1), b3 + hstep, voffB);
            PG8_WAIT_V(6); PG8_BAR; PG8_MMA(1, 1, At, B1); PG8_BAR;
            }
        }
        if constexpr (ALIGN_EPI) { if (wr == 0) PG8_BAR; }
        if constexpr (!Epi::AFTER_DRAIN) { E(acc, cur, wr, wc, fr, fq); S.done(cur); }
        if (!has_next) break;
#pragma unroll
        for (int a = 0; a < 2; ++a)
#pragma unroll
            for (int b = 0; b < 2; ++b)
#pragma unroll
                for (int m = 0; m < 4; ++m)
#pragma unroll
                    for (int n = 0; n < 2; ++n) acc[a][b][m][n] = (f32x4){0.f, 0.f, 0.f, 0.f};
        cur = nxt; cA = nA; cB = nB; ++ui;
        if constexpr (ALIGN_EPI) { if (wr == 1) PG8_BAR; }
    }
    PG8_WAIT_V(0);
    if constexpr (!ALIGN_EPI) { if (wr == 0) PG8_BAR; }
    PG8_BAR;
    if constexpr (Epi::AFTER_DRAIN) { E.fused(acc, cur, wr, wc, fr, fq, lds, wid, lane); S.done(cur); }
#undef PG8_SA
#undef PG8_SB
#undef PG8_STAGE
#undef PG8_LDA
#undef PG8_LDB
#undef PG8_MMA
#undef PG8_WAIT_V
#undef PG8_WAIT_L
#undef PG8_BAR
#undef PG8_SCHED
}
}

constexpr int NWAVES = 8;
constexpr int NPHASE = 23;
constexpr int N_LAUNCHES = MK_N_LAUNCHES;
static_assert(N_LAUNCHES == 1 || N_LAUNCHES == NPHASE, "MK_N_LAUNCHES is 1 or NPHASE");
constexpr int BATCH = 8, SEQ = 2048, D = 2048, FF = 5632, M = BATCH * SEQ;
constexpr int HYB_N = 45 * 256;
constexpr float NORM_EPS = 1e-6f;
constexpr float QSCALE = 0.08838834764831845f * 1.4426950408889634f;

constexpr size_t MiB = 1u << 20;
constexpr size_t WS_CTL = 0, CTL_ZERO_BYTES = 1 * MiB;
constexpr size_t WS_MODV = 1 * MiB;
constexpr size_t MODV_N = 2 * 3 * 8 * 2048;
constexpr size_t WS_ROPE = 3 * MiB;
constexpr size_t WS_WGU = 11 * MiB, WGU_SZ = 44 * MiB;
constexpr size_t WS_WDN = 187 * MiB, WDN_SZ = 22 * MiB;
constexpr size_t WS_WHIN = 275 * MiB, WS_WHOUT = 320 * MiB, WS_WSIN = 336 * MiB, WS_WSOUT = 368 * MiB;
constexpr size_t WS_H = 384 * MiB, WS_F = 448 * MiB, WS_BIG = 512 * MiB;
constexpr size_t WS_HID = WS_BIG;
constexpr size_t WS_Z = WS_BIG, WS_Q = WS_BIG + 64 * MiB, WS_K = WS_BIG + 128 * MiB, WS_V = WS_BIG + 192 * MiB, WS_XBCC = WS_BIG + 256 * MiB, WS_LSE = WS_BIG + 352 * MiB;
constexpr size_t WS_DT = WS_BIG + 355 * MiB, WS_DTS = WS_BIG + 357 * MiB, WS_ACS = WS_BIG + 359 * MiB, WS_SSQ = WS_BIG + 361 * MiB, WS_XBC = WS_BIG + 363 * MiB, WS_A2H = WS_XBC;
constexpr size_t WS_O1 = WS_F, WS_O2 = WS_H;
constexpr int UV_LD = 8192 + 256;
constexpr size_t WS_UV = WS_BIG, WS_A2S = WS_BIG + 264 * MiB, WS_VSTAT = WS_BIG + 392 * MiB;
constexpr size_t WS_XB = WS_BIG + 522 * MiB;
constexpr size_t WS_END = WS_XB + 64 * MiB;
static_assert(WS_A2H + 128 * MiB <= WS_XB && WS_LSE + 3 * MiB <= WS_DT && WS_A2S + 128 * MiB <= WS_VSTAT && WS_VSTAT + 8 * MiB <= WS_XB && WS_UV + (size_t)M * UV_LD * 2 <= WS_A2S && WS_HID + (size_t)M * FF * 2 <= WS_END, "ws map");
constexpr int CW_TMO = 0, CW_CODE = 1, CW_BAR = 4096;

constexpr int RING_OFF = 0, RING_BYTES = 131072;
constexpr int LDS_BYTES = 163840;
constexpr int LDSCTL_OFF = LDS_BYTES - 512, MISC_OFF = LDSCTL_OFF + 320;

#define GAS __attribute__((address_space(1)))
#define LAS __attribute__((address_space(3)))
typedef unsigned short bf16;
typedef unsigned v4u __attribute__((ext_vector_type(4)));
typedef unsigned v2u __attribute__((ext_vector_type(2)));
typedef float f32x4 __attribute__((ext_vector_type(4)));
typedef GAS unsigned gu32;
typedef short bf16x8 __attribute__((ext_vector_type(8)));
typedef short s16x4 __attribute__((ext_vector_type(4)));
#define RLX_AGENT __ATOMIC_RELAXED, __HIP_MEMORY_SCOPE_AGENT
#define LDS_WAIT() asm volatile("s_waitcnt lgkmcnt(0)" ::: "memory")
#define VM_WAIT() asm volatile("s_waitcnt vmcnt(0)" ::: "memory")
__device__ __forceinline__ float bf2f(unsigned short b) { return __uint_as_float(((unsigned)b) << 16); }
__device__ __forceinline__ float bflo(unsigned w) { return __uint_as_float(w << 16); }
__device__ __forceinline__ float bfhi(unsigned w) { return __uint_as_float(w & 0xffff0000u); }
__device__ __forceinline__ unsigned pk2(float lo, float hi) { return pg8::cvt_pk_bf16(lo, hi); }
__device__ __forceinline__ unsigned short f2bf(float f) { return (unsigned short)(pg8::cvt_pk_bf16(f, 0.f) & 0xffffu); }
__device__ __forceinline__ float wave_sum(float v) {
#pragma unroll
    for (int o = 1; o < 64; o <<= 1) v += __shfl_xor(v, o);
    return v;
}
__device__ __forceinline__ float wave_max(float v) {
#pragma unroll
    for (int o = 1; o < 64; o <<= 1) v = fmaxf(v, __shfl_xor(v, o));
    return v;
}
__device__ __forceinline__ float silu_f(float x) { return x / (1.0f + __expf(-x)); }

#define XB_TMO      128
#define XB_XCNT(j)  (256  + 64 * (j))
#define XB_XSUB(j)  (1280 + 64 * (j))
#define XB_XGEN(j)  (2304 + 64 * (j))
#define XB_TOP      3328
#define XB_TOPGEN   3392
#define XCD_BAR_WORDS 3456
#define XB_SPIN_CAP (1u << 18)

__device__ __forceinline__ unsigned xb_ld(unsigned* p)              { return __hip_atomic_load(p, __ATOMIC_RELAXED, __HIP_MEMORY_SCOPE_AGENT); }
__device__ __forceinline__ unsigned xb_add(unsigned* p, unsigned v) { return __hip_atomic_fetch_add(p, v, __ATOMIC_RELAXED, __HIP_MEMORY_SCOPE_AGENT); }
__device__ __forceinline__ unsigned xb_xcc_id() { return (unsigned)__builtin_amdgcn_s_getreg((3 << 11) | 20) & 0xFu; }
#define XB_SPIN(cond, bar) do { unsigned _sp = 0; while (cond) { __builtin_amdgcn_s_sleep(1); \
    if ((++_sp & 255u) == 0u) { if (xb_ld(&(bar)[XB_TMO])) break; if (_sp > XB_SPIN_CAP) { atomicAdd(&(bar)[XB_TMO], 1u); break; } } } } while (0)

struct XcdBarrier {
    unsigned* bar; unsigned x;
    volatile LAS unsigned* st;
};

__device__ __forceinline__ XcdBarrier xcd_barrier_post(unsigned* bar, volatile LAS unsigned* st) {
    XcdBarrier b; b.bar = bar; b.x = xb_xcc_id(); b.st = st;
    if (threadIdx.x == 0) (void)xb_add(&bar[XB_XCNT(b.x)], 1u);
    return b;
}
__device__ __forceinline__ void xcd_barrier_complete(unsigned* bar, unsigned x, unsigned& nloc, unsigned& nx) {
    const unsigned G = gridDim.x * gridDim.y * gridDim.z;
    unsigned sum, cnt, mine, sp = 0u;
    for (;;) {
        sum = 0u; cnt = 0u; mine = 0u;
#pragma unroll
        for (unsigned j = 0; j < 16; ++j) { const unsigned c = xb_ld(&bar[XB_XCNT(j)]); sum += c; cnt += (c > 0u) ? 1u : 0u; mine = (j == x) ? c : mine; }
        if (sum == G) break;
        __builtin_amdgcn_s_sleep(1);
        if ((++sp & 255u) == 0u) { if (xb_ld(&bar[XB_TMO])) break; if (sp > XB_SPIN_CAP) { atomicAdd(&bar[XB_TMO], 1u); break; } }
    }
    nloc = mine > 0u ? mine : 1u; nx = cnt > 0u ? cnt : 1u;
}

__device__ __forceinline__ void xcd_barrier(const XcdBarrier& b) {
    asm volatile("s_waitcnt vmcnt(0)" ::: "memory");
    __syncthreads();
    if (threadIdx.x == 0) {
        unsigned* bar = b.bar;
        __builtin_amdgcn_s_waitcnt(0);
        unsigned nloc = b.st[0], nx = b.st[1];
        if (nloc == 0u) { xcd_barrier_complete(bar, b.x, nloc, nx); b.st[0] = nloc; b.st[1] = nx; }
        const unsigned old = xb_add(&bar[XB_XSUB(b.x)], 1u);
        const unsigned gen = old / nloc;
        if (old + 1u == (gen + 1u) * nloc) {
            __builtin_amdgcn_fence(__ATOMIC_RELEASE, "agent");
            asm volatile("s_waitcnt vmcnt(0)" ::: "memory");
            const unsigned og = xb_add(&bar[XB_TOP], 1u);
            const unsigned tg = og / nx;
            if (og + 1u == (tg + 1u) * nx) xb_add(&bar[XB_TOPGEN], 1u);
            else XB_SPIN(xb_ld(&bar[XB_TOPGEN]) == tg, bar);
            __builtin_amdgcn_fence(__ATOMIC_ACQUIRE, "agent");
            xb_add(&bar[XB_XGEN(b.x)], 1u);
            asm volatile("s_waitcnt vmcnt(0)" ::: "memory");
        } else {
            XB_SPIN(xb_ld(&bar[XB_XGEN(b.x)]) == gen, bar);
            __builtin_amdgcn_fence(__ATOMIC_ACQUIRE, "agent");
            asm volatile("s_waitcnt vmcnt(0)" ::: "memory");
        }
    }
    __syncthreads();
}

struct Frame {
    LAS unsigned char* lds;
    volatile LAS unsigned* MISC;
    gu32* ctl;
    int tid, lane, wave;
    int vcu, G;
    unsigned char* ws;
};

__device__ __forceinline__ void transpose_item(const float* W, int N, int K, bf16* WT, int k0, int n0, int drow0, LAS float* scr, int lane, const float* kscale = nullptr) {
    float tv[32];
#pragma unroll
    for (int i = 0; i < 32; ++i) { const int kk = 2 * i + (lane >> 5); tv[i] = W[(size_t)(k0 + kk) * N + n0 + (lane & 31)]; }
#pragma unroll
    for (int i = 0; i < 32; ++i) { const int kk = 2 * i + (lane >> 5); scr[kk * 33 + (lane & 31)] = kscale ? tv[i] * kscale[k0 + kk] : tv[i]; }
    LDS_WAIT(); asm volatile("" ::: "memory");
    const int c = lane & 7;
#pragma unroll
    for (int j = 0; j < 4; ++j) { const int n = (lane >> 3) + 8 * j; const LAS float* s = scr + (8 * c) * 33 + n;
        v4u o; o.x = pk2(s[0 * 33], s[1 * 33]); o.y = pk2(s[2 * 33], s[3 * 33]); o.z = pk2(s[4 * 33], s[5 * 33]); o.w = pk2(s[6 * 33], s[7 * 33]);
        *(GAS v4u*)(WT + (size_t)(drow0 + n) * K + k0 + 8 * c) = o; }
    LDS_WAIT(); asm volatile("" ::: "memory");
}
__device__ __forceinline__ void transpose_item64(const float* W, int N, int K, bf16* WT, int k0, int n0, int drowA, int drowB, LAS float* scr, int lane, const float* kscale = nullptr) {
    float tv[64];
#pragma unroll
    for (int i = 0; i < 64; ++i) tv[i] = W[(size_t)(k0 + i) * N + n0 + lane];
#pragma unroll
    for (int i = 0; i < 64; ++i) scr[i * 65 + lane] = kscale ? tv[i] * kscale[k0 + i] : tv[i];
    LDS_WAIT(); asm volatile("" ::: "memory");
    const int c = lane & 7;
#pragma unroll
    for (int j = 0; j < 8; ++j) { const int n = (lane >> 3) + 8 * j; const LAS float* s = scr + (8 * c) * 65 + n;
        v4u o; o.x = pk2(s[0 * 65], s[1 * 65]); o.y = pk2(s[2 * 65], s[3 * 65]); o.z = pk2(s[4 * 65], s[5 * 65]); o.w = pk2(s[6 * 65], s[7 * 65]);
        const int drow = n < 32 ? drowA + n : drowB + (n - 32);
        *(GAS v4u*)(WT + (size_t)drow * K + k0 + 8 * c) = o; }
    LDS_WAIT(); asm volatile("" ::: "memory");
}
__device__ __forceinline__ int hyb_in_row(int n0) {
    if (n0 < 5120) return n0;
    if (n0 < 5152) return 44 * 256;
    int c, base;
    if (n0 < 7200) { c = n0 - 5152; base = 20 * 256; } else if (n0 < 9248) { c = n0 - 7200; base = 28 * 256; } else return 36 * 256 + (n0 - 9248);
    const int head = c >> 7, d = c & 127, half = d >> 6, j = d & 63;
    return base + (head >> 1) * 256 + half * 128 + (head & 1) * 64 + j;
}
__device__ __forceinline__ void p0_prologue(Frame& F, const float* const* in) {
    const float* c_in = in[1]; const float* w_mod = in[3]; const float* b_mod = in[4]; const float* norm_pre = in[5]; const float* norm_post = in[6];
    float* SHIFT = (float*)(F.ws + WS_MODV); float* APRE = SHIFT + MODV_N; float* APOST = APRE + MODV_N;
    {
        LAS float* ca = (LAS float*)(F.lds);
        LAS float* red = (LAS float*)(F.lds + 65536);
        for (int e = F.tid; e < 8 * 2048; e += NWAVES * 64) { const int b = e >> 11, k = e & 2047; const float v = c_in[e]; ca[k * 8 + b] = v / (1.0f + expf(-v)); }
        __syncthreads();
        for (int item = blockIdx.x; item < 256; item += F.G) {
            const int n0 = item * 144, l = n0 / 18432, nl = n0 % 18432; const bool act = F.lane < 36;
            f32x4 acc[8];
#pragma unroll
            for (int b = 0; b < 8; ++b) acc[b] = (f32x4){0.f, 0.f, 0.f, 0.f};
            const float* wp = w_mod + ((size_t)l * 2048 + F.wave * 256) * 18432 + nl + 4 * (act ? F.lane : 0);
#pragma unroll 8
            for (int k = 0; k < 256; ++k) { const f32x4 wv = *(const f32x4*)(wp + (size_t)k * 18432); const LAS f32x4* cp = (const LAS f32x4*)(ca + (F.wave * 256 + k) * 8); const f32x4 c0 = cp[0], c1 = cp[1];
                acc[0] += wv * c0[0]; acc[1] += wv * c0[1]; acc[2] += wv * c0[2]; acc[3] += wv * c0[3]; acc[4] += wv * c1[0]; acc[5] += wv * c1[1]; acc[6] += wv * c1[2]; acc[7] += wv * c1[3]; }
            if (act) {
#pragma unroll
                for (int b = 0; b < 8; ++b) *(LAS f32x4*)(red + (F.wave * 8 + b) * 144 + 4 * F.lane) = acc[b]; }
            __syncthreads();
            for (int e = F.tid; e < 8 * 144; e += NWAVES * 64) { const int b = e / 144, cl = e % 144, n = nl + cl; float s = b_mod[l * 18432 + n];
#pragma unroll
                for (int w = 0; w < 8; ++w) s += red[(w * 8 + b) * 144 + cl];
                const int sub = n / 6144, kind = (n % 6144) >> 11, d = n & 2047; const size_t idx = ((size_t)(l * 3 + sub) * 8 + b) * 2048 + d; const int gi = (l * 3 + sub) * 2048 + d;
                if (kind == 0) SHIFT[idx] = s; else if (kind == 1) APRE[idx] = norm_pre[gi] * (1.0f + s); else APOST[idx] = (sub == 1 ? 1.0f : 0.5f) * (1.0f + s) * norm_post[gi]; }
            __syncthreads();
        }
    }
    {
        __syncthreads();
        LAS float* scr = (LAS float*)(F.lds + F.wave * 16640);
        const int gw = F.vcu * NWAVES + F.wave, NGW = F.G * NWAVES;
        constexpr int I_F = 32 * 88, I_HIN = 32 * 176, I_DT = 32, I_O = 64 * 32, I_SIN = 32 * 128;
        constexpr int NITEMS = 12 * I_F + I_HIN + I_DT + I_O + I_SIN + I_O;
        for (int it = gw; it < NITEMS; it += NGW) {
            int r = NITEMS - 1 - it;
            if (r < 12 * I_F) {
                const int f = r / (3 * I_F), which = (r / I_F) % 3, q = r % I_F;
                if (which < 2) { const int kb = q / 88, n0 = (q % 88) * 64; const float* W = (which == 0 ? in[7] : in[8]) + (size_t)f * 2048 * 5632; const int dr = (n0 >> 7) * 256 + which * 128 + (n0 & 127);
                    transpose_item64(W, 5632, 2048, (bf16*)(F.ws + WS_WGU + f * WGU_SZ), kb * 64, n0, dr, dr + 32, scr, F.lane); }
                else { const int kb = q / 32, n0 = (q % 32) * 64; transpose_item64(in[9] + (size_t)f * 5632 * 2048, 2048, 5632, (bf16*)(F.ws + WS_WDN + f * WDN_SZ), kb * 64, n0, n0, n0 + 32, scr, F.lane); }
                continue; }
            r -= 12 * I_F;
            if (r < I_HIN) { const int kb = r / 176, p_ = r % 176, n0 = p_ < 80 ? 64 * p_ : 5152 + 64 * (p_ - 80);
                transpose_item64(in[10], 11296, 2048, (bf16*)(F.ws + WS_WHIN), kb * 64, n0, hyb_in_row(n0), hyb_in_row(n0 + 32), scr, F.lane); continue; } r -= I_HIN;
            if (r < I_DT) { transpose_item(in[10], 11296, 2048, (bf16*)(F.ws + WS_WHIN), r * 64, 5120, hyb_in_row(5120), scr, F.lane); continue; } r -= I_DT;
            if (r < I_O) { const int kb = r / 32, n0 = (r % 32) * 64; transpose_item64(in[17], 2048, 4096, (bf16*)(F.ws + WS_WHOUT), kb * 64, n0, n0, n0 + 32, scr, F.lane, kb < 32 ? in[16] : nullptr); continue; } r -= I_O;
            if (r < I_SIN) { const int kb = r / 128, n0 = (r % 128) * 64; transpose_item64(in[18], 8192, 2048, (bf16*)(F.ws + WS_WSIN), kb * 64, n0, n0, n0 + 32, scr, F.lane); continue; } r -= I_SIN;
            { const int kb = r / 32, n0 = (r % 32) * 64; transpose_item64(in[24], 2048, 4096, (bf16*)(F.ws + WS_WSOUT), kb * 64, n0, n0, n0 + 32, scr, F.lane); }
        }
    }
}

template <bool HAS_F, bool HAS_H, bool XIN16, bool XOUT16>
__device__ __forceinline__ void rowpass(Frame& F, const void* xin_, void* xout_, const bf16* fbuf, const float* apost, const float* apre, const float* shift, bf16* hout) {
    const int gw = F.vcu * NWAVES + F.wave;
    for (int rb = gw; rb < M / 8; rb += F.G * NWAVES) {
        const int r0 = rb * 8, b = r0 >> 11;
        f32x4 ap[8], pr[8], sh[8];
#pragma unroll
        for (int j = 0; j < 8; ++j) { const int c = 4 * F.lane + 256 * j;
            if (HAS_F) ap[j] = *(const f32x4*)(apost + b * 2048 + c);
            if (HAS_H) { pr[j] = *(const f32x4*)(apre + b * 2048 + c); sh[j] = *(const f32x4*)(shift + b * 2048 + c); } }
        for (int rr = 0; rr < 8; ++rr) {
            const size_t r = (size_t)(r0 + rr);
            f32x4 xv[8];
#pragma unroll
            for (int j = 0; j < 8; ++j) { const size_t o = r * D + 4 * F.lane + 256 * j;
                if (XIN16) { const v2u w = *(const v2u*)((const bf16*)xin_ + o); xv[j] = (f32x4){bflo(w.x), bfhi(w.x), bflo(w.y), bfhi(w.y)}; } else xv[j] = *(const f32x4*)((const float*)xin_ + o); }
            if (HAS_F) {
                f32x4 fv[8]; float ss = 0.f;
#pragma unroll
                for (int j = 0; j < 8; ++j) { const v2u w = *(const v2u*)(fbuf + r * D + 4 * F.lane + 256 * j); fv[j] = (f32x4){bflo(w.x), bfhi(w.x), bflo(w.y), bfhi(w.y)};
                    ss += (fv[j][0] * fv[j][0] + fv[j][1] * fv[j][1]) + (fv[j][2] * fv[j][2] + fv[j][3] * fv[j][3]); }
                const float rstd = rsqrtf(wave_sum(ss) * (1.0f / D) + NORM_EPS);
#pragma unroll
                for (int j = 0; j < 8; ++j) { xv[j] = xv[j] + ap[j] * fv[j] * rstd; const size_t o = r * D + 4 * F.lane + 256 * j;
                    if (XOUT16) { v2u w; w.x = pk2(xv[j][0], xv[j][1]); w.y = pk2(xv[j][2], xv[j][3]); *(v2u*)((bf16*)xout_ + o) = w; } else *(f32x4*)((float*)xout_ + o) = xv[j]; }
            }
            if (HAS_H) {
                float ss = 0.f;
#pragma unroll
                for (int j = 0; j < 8; ++j) ss += (xv[j][0] * xv[j][0] + xv[j][1] * xv[j][1]) + (xv[j][2] * xv[j][2] + xv[j][3] * xv[j][3]);
                const float rstd = rsqrtf(wave_sum(ss) * (1.0f / D) + NORM_EPS);
#pragma unroll
                for (int j = 0; j < 8; ++j) { const f32x4 hv = xv[j] * rstd * pr[j] + sh[j]; v2u w; w.x = pk2(hv[0], hv[1]); w.y = pk2(hv[2], hv[3]); *(v2u*)(hout + r * D + 4 * F.lane + 256 * j) = w; }
            }
        }
    }
}

__device__ __forceinline__ void dt_minigemm(Frame& F, const bf16* Hb, const bf16* Wt, float* DT) {
    const int gw = F.vcu * NWAVES + F.wave, fr = F.lane & 15, fq = F.lane >> 4;
    for (int it = gw; it < M / 8; it += F.G * NWAVES) {
        const int rb = it >> 1, ch = it & 1;
        const bf16* ap = Hb + (size_t)(16 * rb + fr) * 2048 + 8 * fq; const bf16* bp = Wt + (size_t)(16 * ch + fr) * 2048 + 8 * fq;
        f32x4 a0 = (f32x4){0.f, 0.f, 0.f, 0.f};
#pragma unroll 16
        for (int ks = 0; ks < 64; ++ks) { const bf16x8 av = *(const bf16x8*)(ap + 32 * ks), wv = *(const bf16x8*)(bp + 32 * ks); a0 = __builtin_amdgcn_mfma_f32_16x16x32_bf16(av, wv, a0, 0, 0, 0); }
#pragma unroll
        for (int rg = 0; rg < 4; ++rg) DT[(size_t)(16 * rb + 4 * fq + rg) * 32 + 16 * ch + fr] = a0[rg];
    }
}

__device__ __forceinline__ void ssd_prepass(Frame& F, const float* const* in) {
    const float* conv_w = in[11]; const float* conv_b = in[12];
    const bf16* __restrict__ XBC = (const bf16*)(F.ws + WS_XBC); bf16* __restrict__ XC = (bf16*)(F.ws + WS_XBCC); const float* DT = (const float*)(F.ws + WS_DT); float* DTS = (float*)(F.ws + WS_DTS); float* ACS = (float*)(F.ws + WS_ACS);
    const int gw = F.vcu * NWAVES + F.wave;
    for (int it = gw; it < 1536 + 128; it += F.G * NWAVES) {
        if (it < 1536) {
            const int b = it / 192, rem = it % 192, slab = rem >> 5, run = rem & 31, ch = slab * 512 + 8 * F.lane, t0 = run * 64;
            float wt[4][8], bs[8];
#pragma unroll
            for (int j = 0; j < 4; ++j) { const f32x4 a = *(const f32x4*)(conv_w + j * 3072 + ch), c = *(const f32x4*)(conv_w + j * 3072 + ch + 4); wt[j][0] = a[0]; wt[j][1] = a[1]; wt[j][2] = a[2]; wt[j][3] = a[3]; wt[j][4] = c[0]; wt[j][5] = c[1]; wt[j][6] = c[2]; wt[j][7] = c[3]; }
            { const f32x4 a = *(const f32x4*)(conv_b + ch), c = *(const f32x4*)(conv_b + ch + 4); bs[0] = a[0]; bs[1] = a[1]; bs[2] = a[2]; bs[3] = a[3]; bs[4] = c[0]; bs[5] = c[1]; bs[6] = c[2]; bs[7] = c[3]; }
            const bf16* src = XBC + (size_t)(b * 2048 + t0) * 3072 + ch; bf16* dst = XC + (size_t)(b * 2048 + t0) * 3072 + ch;
            pg8::f32x2 wv[4][4], bv2[4], q0[4], q1[4], q2[4];
#pragma unroll
            for (int e = 0; e < 4; ++e) { bv2[e] = (pg8::f32x2){bs[2 * e], bs[2 * e + 1]};
#pragma unroll
                for (int j = 0; j < 4; ++j) wv[j][e] = (pg8::f32x2){wt[j][2 * e], wt[j][2 * e + 1]}; }
#define CV_UNPACK(dst, v) do { dst[0] = (pg8::f32x2){bflo((v).x), bfhi((v).x)}; dst[1] = (pg8::f32x2){bflo((v).y), bfhi((v).y)}; dst[2] = (pg8::f32x2){bflo((v).z), bfhi((v).z)}; dst[3] = (pg8::f32x2){bflo((v).w), bfhi((v).w)}; } while (0)
            { v4u h0 = (v4u){0u, 0u, 0u, 0u}, h1 = h0, h2 = h0;
              if (t0 > 0) { h0 = *(const v4u*)(src - 3 * 3072); h1 = *(const v4u*)(src - 2 * 3072); h2 = *(const v4u*)(src - 3072); }
              CV_UNPACK(q0, h0); CV_UNPACK(q1, h1); CV_UNPACK(q2, h2); }
            v4u rn[8];
#pragma unroll
            for (int i = 0; i < 8; ++i) rn[i] = *(const v4u*)(src + (size_t)i * 3072);
            for (int tb = 0; tb < 64; tb += 8) {
                v4u rw[8];
#pragma unroll
                for (int i = 0; i < 8; ++i) rw[i] = rn[i];
                if (tb + 8 < 64) {
#pragma unroll
                    for (int i = 0; i < 8; ++i) rn[i] = *(const v4u*)(src + (size_t)(tb + 8 + i) * 3072); }
#pragma unroll
                for (int i = 0; i < 8; ++i) { pg8::f32x2 q3[4]; CV_UNPACK(q3, rw[i]); pg8::f32x2 o[4];
#pragma unroll
                    for (int e = 0; e < 4; ++e) { const pg8::f32x2 c = bv2[e] + wv[0][e] * q0[e] + wv[1][e] * q1[e] + wv[2][e] * q2[e] + wv[3][e] * q3[e];
                        const pg8::f32x2 t = c * (-1.4426950408889634f); pg8::f32x2 ex; ex.x = __builtin_amdgcn_exp2f(t.x); ex.y = __builtin_amdgcn_exp2f(t.y); const pg8::f32x2 d = ex + 1.0f;
                        pg8::f32x2 r; r.x = __builtin_amdgcn_rcpf(d.x); r.y = __builtin_amdgcn_rcpf(d.y); o[e] = c * r; q0[e] = q1[e]; q1[e] = q2[e]; q2[e] = q3[e]; }
                    v4u ov; ov.x = pk2(o[0].x, o[0].y); ov.y = pk2(o[1].x, o[1].y); ov.z = pk2(o[2].x, o[2].y); ov.w = pk2(o[3].x, o[3].y);
                    *(v4u*)(dst + (size_t)(tb + i) * 3072) = ov; }
            }
#undef CV_UNPACK
        } else {
            const int bc = it - 1536, h = F.lane & 31; const size_t row0 = (size_t)bc * 128;
            if (F.lane < 32) { const float a = -expf(in[14][h]), dtb = in[13][h]; float cum = 0.f;
                float rnx[16];
#pragma unroll
                for (int i = 0; i < 16; ++i) rnx[i] = DT[(row0 + i) * 32 + h];
                for (int l0 = 0; l0 < 128; l0 += 16) { float rv[16];
#pragma unroll
                    for (int i = 0; i < 16; ++i) rv[i] = rnx[i];
                    if (l0 + 16 < 128) {
#pragma unroll
                        for (int i = 0; i < 16; ++i) rnx[i] = DT[(row0 + l0 + 16 + i) * 32 + h]; }
#pragma unroll
                    for (int i = 0; i < 16; ++i) { const float raw = rv[i] + dtb; const float dt = fmaxf(raw, 0.f) + __logf(1.0f + __expf(-fabsf(raw))); cum += a * dt; DTS[(row0 + l0 + i) * 32 + h] = dt; ACS[(row0 + l0 + i) * 32 + h] = cum; } } }
        }
    }
}
constexpr int SS_BP = 288, SS_CP = 272, SS_XP = 160;
constexpr int SS_BM = 0, SS_CM = 128 * SS_BP, SS_XR = SS_CM + 128 * SS_CP, SS_XW = SS_XR + 128 * SS_XP, SS_ST = SS_XW + 128 * SS_XP, SS_ACS = SS_ST + 128 * SS_XP, SS_DT = SS_ACS + 512;
static_assert(SS_DT + 512 <= LDSCTL_OFF, "ssd LDS map");
__device__ __forceinline__ bf16x8 ld_perm(const LAS unsigned char* p) { const v2u lo = *(const LAS v2u*)p, hi = *(const LAS v2u*)(p + 32); return __builtin_bit_cast(bf16x8, (v4u){lo.x, lo.y, hi.x, hi.y}); }
__device__ __forceinline__ bf16x8 ld_tr2(const LAS unsigned char* p, int pitch16) { const s16x4 lo = __builtin_amdgcn_ds_read_tr16_b64_v4i16((LAS s16x4*)p); const s16x4 hi = __builtin_amdgcn_ds_read_tr16_b64_v4i16((LAS s16x4*)(p + pitch16)); return __builtin_shufflevector(lo, hi, 0, 1, 2, 3, 4, 5, 6, 7); }
__device__ __forceinline__ void ssd_unit_mfma(Frame& F, int b, int h, const float* const* in) {
    const bf16* XC = (const bf16*)(F.ws + WS_XBCC); const float* DTS = (const float*)(F.ws + WS_DTS); const float* ACS = (const float*)(F.ws + WS_ACS); const bf16* Z = (const bf16*)(F.ws + WS_Z); bf16* A2 = (bf16*)(F.ws + WS_A2H); float* SSQ = (float*)(F.ws + WS_SSQ);
    LAS unsigned char* Bm = F.lds + SS_BM; LAS unsigned char* Cm = F.lds + SS_CM; LAS unsigned char* Xr = F.lds + SS_XR; LAS unsigned char* Xw = F.lds + SS_XW; LAS unsigned char* ST = F.lds + SS_ST;
    LAS float* acsS = (LAS float*)(F.lds + SS_ACS); LAS float* dtS = (LAS float*)(F.lds + SS_DT);
    const int w = F.wave, lane = F.lane, fr = lane & 15, fq = lane >> 4, tid = F.tid, g = h >> 3;
    const int trow = 4 * fq + ((lane & 15) >> 2), tcol = (lane & 3) * 8;
    const float dsk = in[15][h];
    f32x4 S[4];
#pragma unroll
    for (int i = 0; i < 4; ++i) S[i] = (f32x4){0.f, 0.f, 0.f, 0.f};
    v4u pfb[4], pfc[4], pfx[2]; float pdt[2], pacs[2], pacsL = 0.f, pdtl = 0.f, pacsl = 0.f;
#define SSD_LOAD(c) do { const size_t row0_ = (size_t)b * 2048 + (size_t)(c) * 128; \
        _Pragma("unroll") for (int j = 0; j < 4; ++j) { const int cc = tid + 512 * j, l = cc >> 4, ch = cc & 15; pfb[j] = *(const v4u*)(XC + (row0_ + l) * 3072 + 2048 + g * 128 + ch * 8); pfc[j] = *(const v4u*)(XC + (row0_ + l) * 3072 + 2560 + g * 128 + ch * 8); } \
        _Pragma("unroll") for (int j = 0; j < 2; ++j) { const int cc = tid + 512 * j, l = cc >> 3, ch = cc & 7; pfx[j] = *(const v4u*)(XC + (row0_ + l) * 3072 + h * 64 + ch * 8); pdt[j] = DTS[(row0_ + l) * 32 + h]; pacs[j] = ACS[(row0_ + l) * 32 + h]; } \
        pacsL = ACS[(row0_ + 127) * 32 + h]; if (tid < 128) { pdtl = DTS[(row0_ + tid) * 32 + h]; pacsl = ACS[(row0_ + tid) * 32 + h]; } } while (0)
    SSD_LOAD(0);
    for (int c = 0; c < 16; ++c) {
        __syncthreads();
#pragma unroll
        for (int i = 0; i < 4; ++i) { const int nb = 4 * (w & 1) + i, pb = w >> 1; v2u sv; sv.x = pk2(S[i][0], S[i][1]); sv.y = pk2(S[i][2], S[i][3]); *(LAS v2u*)(ST + (16 * nb + fr) * SS_XP + (16 * pb + 4 * fq) * 2) = sv; }
#pragma unroll
        for (int j = 0; j < 4; ++j) { const int cc = tid + 512 * j, l = cc >> 4, ch = cc & 15; *(LAS v4u*)(Bm + l * SS_BP + ch * 16) = pfb[j]; *(LAS v4u*)(Cm + l * SS_CP + ch * 16) = pfc[j]; }
#pragma unroll
        for (int j = 0; j < 2; ++j) { const int cc = tid + 512 * j, l = cc >> 3, ch = cc & 7; *(LAS v4u*)(Xr + l * SS_XP + ch * 16) = pfx[j]; const float wl = pdt[j] * __expf(pacsL - pacs[j]);
            v4u xw; xw.x = pk2(bflo(pfx[j].x) * wl, bfhi(pfx[j].x) * wl); xw.y = pk2(bflo(pfx[j].y) * wl, bfhi(pfx[j].y) * wl); xw.z = pk2(bflo(pfx[j].z) * wl, bfhi(pfx[j].z) * wl); xw.w = pk2(bflo(pfx[j].w) * wl, bfhi(pfx[j].w) * wl);
            *(LAS v4u*)(Xw + l * SS_XP + ch * 16) = xw; }
        if (tid < 128) { acsS[tid] = pacsl; dtS[tid] = pdtl; }
        const float eL = __expf(pacsL);
        __syncthreads();
        const int l = 16 * w + fr; const size_t zrow = ((size_t)b * 2048 + (size_t)c * 128 + l) * 2048 + h * 64 + 4 * fq;
        v2u zv[4];
#pragma unroll
        for (int pb = 0; pb < 4; ++pb) zv[pb] = *(const v2u*)(Z + zrow + 16 * pb);
        asm volatile("" ::: "memory");
        if (c + 1 < 16) SSD_LOAD(c + 1);
        bf16x8 cf[4];
#pragma unroll
        for (int ks = 0; ks < 4; ++ks) cf[ks] = ld_perm(Cm + l * SS_CP + (32 * ks + 4 * fq) * 2);
        f32x4 acc[4];
#pragma unroll
        for (int pb = 0; pb < 4; ++pb) acc[pb] = (f32x4){0.f, 0.f, 0.f, 0.f};
        {
            bf16x8 sfA[4], sfB[4];
#define SSD_LDS_ST(dst, ks_) _Pragma("unroll") for (int pb = 0; pb < 4; ++pb) dst[pb] = ld_tr2(ST + (32 * (ks_) + trow) * SS_XP + 32 * pb + tcol, 16 * SS_XP)
#define SSD_MMA_ST(src, ks_) _Pragma("unroll") for (int pb = 0; pb < 4; ++pb) acc[pb] = __builtin_amdgcn_mfma_f32_16x16x32_bf16(src[pb], cf[ks_], acc[pb], 0, 0, 0)
            SSD_LDS_ST(sfA, 0); SSD_MMA_ST(sfA, 0); SSD_LDS_ST(sfB, 1); SSD_MMA_ST(sfB, 1); SSD_LDS_ST(sfA, 2); SSD_MMA_ST(sfA, 2); SSD_LDS_ST(sfB, 3); SSD_MMA_ST(sfB, 3);
#undef SSD_LDS_ST
#undef SSD_MMA_ST
        }
        const float acs_l = acsS[l], el = __expf(acs_l);
#pragma unroll
        for (int pb = 0; pb < 4; ++pb) acc[pb] = acc[pb] * el;
#pragma unroll
        for (int kk = 0; kk < 4; ++kk) if (2 * kk <= w) {
            const int sa = 32 * kk, hasb = (2 * kk + 1 <= w), sb = hasb ? sa + 16 : sa;
            f32x4 ga = (f32x4){0.f, 0.f, 0.f, 0.f}, gb = ga;
#pragma unroll
            for (int ks = 0; ks < 4; ++ks) { const bf16x8 fa = ld_perm(Bm + (sa + fr) * SS_BP + (32 * ks + 4 * fq) * 2); ga = __builtin_amdgcn_mfma_f32_16x16x32_bf16(fa, cf[ks], ga, 0, 0, 0);
                if (hasb) { const bf16x8 fb = ld_perm(Bm + (sb + fr) * SS_BP + (32 * ks + 4 * fq) * 2); gb = __builtin_amdgcn_mfma_f32_16x16x32_bf16(fb, cf[ks], gb, 0, 0, 0); } }
            const f32x4 aa = *(const LAS f32x4*)(acsS + sa + 4 * fq), da = *(const LAS f32x4*)(dtS + sa + 4 * fq), ab = *(const LAS f32x4*)(acsS + sb + 4 * fq), db = *(const LAS f32x4*)(dtS + sb + 4 * fq);
#pragma unroll
            for (int rg = 0; rg < 4; ++rg) { const int s1 = sa + 4 * fq + rg, s2 = sa + 16 + 4 * fq + rg;
                ga[rg] = (s1 <= l) ? ga[rg] * __expf(acs_l - aa[rg]) * da[rg] : 0.f; gb[rg] = (hasb && s2 <= l) ? gb[rg] * __expf(acs_l - ab[rg]) * db[rg] : 0.f; }
            v4u mw; mw.x = pk2(ga[0], ga[1]); mw.y = pk2(ga[2], ga[3]); mw.z = pk2(gb[0], gb[1]); mw.w = pk2(gb[2], gb[3]);
            const bf16x8 mf = __builtin_bit_cast(bf16x8, mw);
            bf16x8 xf[4];
#pragma unroll
            for (int pb = 0; pb < 4; ++pb) { const s16x4 lo = __builtin_amdgcn_ds_read_tr16_b64_v4i16((LAS s16x4*)(Xr + (sa + trow) * SS_XP + 32 * pb + tcol)); const s16x4 hi = __builtin_amdgcn_ds_read_tr16_b64_v4i16((LAS s16x4*)(Xr + (sb + trow) * SS_XP + 32 * pb + tcol));
                xf[pb] = __builtin_shufflevector(lo, hi, 0, 1, 2, 3, 4, 5, 6, 7); }
#pragma unroll
            for (int pb = 0; pb < 4; ++pb) acc[pb] = __builtin_amdgcn_mfma_f32_16x16x32_bf16(xf[pb], mf, acc[pb], 0, 0, 0);
        }
        float ssq = 0.f; const size_t arow = ((size_t)b * 2048 + (size_t)c * 128 + l) * 4096 + h * 64 + 4 * fq;
#pragma unroll
        for (int pb = 0; pb < 4; ++pb) { const v2u xr = *(const LAS v2u*)(Xr + l * SS_XP + (16 * pb + 4 * fq) * 2);
            const float y0 = (acc[pb][0] + bflo(xr.x) * dsk) * pg8::fast_silu(bflo(zv[pb].x)), y1 = (acc[pb][1] + bfhi(xr.x) * dsk) * pg8::fast_silu(bfhi(zv[pb].x));
            const float y2 = (acc[pb][2] + bflo(xr.y) * dsk) * pg8::fast_silu(bflo(zv[pb].y)), y3 = (acc[pb][3] + bfhi(xr.y) * dsk) * pg8::fast_silu(bfhi(zv[pb].y));
            ssq += (y0 * y0 + y1 * y1) + (y2 * y2 + y3 * y3);
            v2u o; o.x = pk2(y0, y1); o.y = pk2(y2, y3); *(v2u*)(A2 + arow + 16 * pb) = o; }
        ssq += __shfl_xor(ssq, 16); ssq += __shfl_xor(ssq, 32);
        if (fq == 0) SSQ[((size_t)b * 2048 + (size_t)c * 128 + l) * 32 + h] = ssq;
        f32x4 sacc[4];
#pragma unroll
        for (int i = 0; i < 4; ++i) sacc[i] = (f32x4){0.f, 0.f, 0.f, 0.f};
        {
            bf16x8 uA[5], uB[5];
#define SSD_LDS_UP(dst, ks_) do { dst[4] = ld_tr2(Xw + (32 * (ks_) + trow) * SS_XP + 32 * (w >> 1) + tcol, 16 * SS_XP); _Pragma("unroll") for (int i = 0; i < 4; ++i) dst[i] = ld_tr2(Bm + (32 * (ks_) + trow) * SS_BP + 32 * (4 * (w & 1) + i) + tcol, 16 * SS_BP); } while (0)
#define SSD_MMA_UP(src) _Pragma("unroll") for (int i = 0; i < 4; ++i) sacc[i] = __builtin_amdgcn_mfma_f32_16x16x32_bf16(src[4], src[i], sacc[i], 0, 0, 0)
            SSD_LDS_UP(uA, 0); SSD_MMA_UP(uA); SSD_LDS_UP(uB, 1); SSD_MMA_UP(uB); SSD_LDS_UP(uA, 2); SSD_MMA_UP(uA); SSD_LDS_UP(uB, 3); SSD_MMA_UP(uB);
#undef SSD_LDS_UP
#undef SSD_MMA_UP
        }
#pragma unroll
        for (int i = 0; i < 4; ++i) S[i] = S[i] * eL + sacc[i];
    }
#undef SSD_LOAD
    __syncthreads();
}
constexpr int ATT_PITCH = 288;
constexpr int ATT_VOFF = 256 * ATT_PITCH;
template <int I0, int I1, bool FUSE>
__device__ __forceinline__ void attn_phase_mfma(Frame& F) {
    const bf16* Q = (const bf16*)(F.ws + WS_Q); const bf16* Kb = (const bf16*)(F.ws + WS_K); const bf16* Vb = (const bf16*)(F.ws + WS_V); float* LSE = (float*)(F.ws + WS_LSE);
    const int w = F.wave, lane = F.lane, fr = lane & 15, fq = lane >> 4, tid = F.tid;
    constexpr int SLOT = 128 * ATT_PITCH;
    for (int ci = blockIdx.x; ci < 256; ci += F.G) {
        const int bh = ci >> 1, half = ci & 1, b = bh >> 4, hd = bh & 15;
        v4u pk[4], pv[4]; bf16x8 qn[4];
#define ATT_UNIT(i, pt, r, n) do { if ((i) < 8) { pt = 0; r = 0; n = 8 * half + (i); } else if ((i) < 16) { pt = 1; r = 2 * half + (((i) - 8) >> 2); n = ((i) - 8) & 3; } else { pt = 2; r = 8 * half + ((i) - 16); n = 0; } } while (0)
#define ATT_LOADBLK(dil_, r_, nb_) do { _Pragma("unroll") for (int j = 0; j < 4; ++j) { const int c = tid + 512 * j, kj = c >> 4, ch = c & 15; const size_t off = (size_t)(b * 2048 + (dil_) * (128 * (nb_) + kj) + (r_)) * 2048 + hd * 128 + ch * 8; pk[j] = *(const v4u*)(Kb + off); pv[j] = *(const v4u*)(Vb + off); } } while (0)
#define ATT_STOREBLK(slot_) do { _Pragma("unroll") for (int j = 0; j < 4; ++j) { const int c = tid + 512 * j, kj = c >> 4, ch = c & 15; *(LAS v4u*)(F.lds + (slot_) * SLOT + kj * ATT_PITCH + ch * 16) = pk[j]; *(LAS v4u*)(F.lds + ATT_VOFF + (slot_) * SLOT + kj * ATT_PITCH + ch * 16) = pv[j]; } } while (0)
#define ATT_ZEROBLK(slot_) do { _Pragma("unroll") for (int j = 0; j < 4; ++j) { const int c = tid + 512 * j, kj = c >> 4, ch = c & 15; *(LAS v4u*)(F.lds + (slot_) * SLOT + kj * ATT_PITCH + ch * 16) = (v4u){0u, 0u, 0u, 0u}; *(LAS v4u*)(F.lds + ATT_VOFF + (slot_) * SLOT + kj * ATT_PITCH + ch * 16) = (v4u){0u, 0u, 0u, 0u}; } } while (0)
        __syncthreads();
        { int pt, r, n; ATT_UNIT(I0, pt, r, n); const int dil0 = pt == 0 ? 1 : (pt == 1 ? 4 : 16);
          if (n > 0) { ATT_LOADBLK(dil0, r, n - 1); ATT_STOREBLK((n - 1) & 1); } else { ATT_ZEROBLK(1); }
          ATT_LOADBLK(dil0, r, n); ATT_STOREBLK(n & 1);
          const size_t q0row = (size_t)(b * 2048 + dil0 * (128 * n + 16 * w + fr) + r);
#pragma unroll
          for (int ks = 0; ks < 4; ++ks) qn[ks] = *(const bf16x8*)(Q + q0row * 2048 + hd * 128 + 32 * ks + 8 * fq); }
        for (int i = I0; i < I1; ++i) {
            int pt, r, n; ATT_UNIT(i, pt, r, n);
            const int dil = pt == 0 ? 1 : (pt == 1 ? 4 : 16);
            bf16* Op = (bf16*)(F.ws + (pt == 0 ? WS_O1 : WS_O2));
            const int qi = 16 * w + fr; const size_t qrow = (size_t)(b * 2048 + dil * (128 * n + qi) + r);
            bf16x8 qf[4];
#pragma unroll
            for (int ks = 0; ks < 4; ++ks) qf[ks] = qn[ks];
            int npt = 0, nr = 0, nn = 0;
            if (i + 1 < I1) { ATT_UNIT(i + 1, npt, nr, nn); const int ndil = npt == 0 ? 1 : (npt == 1 ? 4 : 16); ATT_LOADBLK(ndil, nr, nn);
                const size_t nqrow = (size_t)(b * 2048 + ndil * (128 * nn + qi) + nr);
#pragma unroll
                for (int ks = 0; ks < 4; ++ks) qn[ks] = *(const bf16x8*)(Q + nqrow * 2048 + hd * 128 + 32 * ks + 8 * fq); }
            __syncthreads();
            const int sprev = (n + 1) & 1, scur = n & 1;
            f32x4 s[9];
#pragma unroll
            for (int kbi = 0; kbi < 9; ++kbi) { s[kbi] = (f32x4){0.f, 0.f, 0.f, 0.f}; const int kb = w + kbi;
                if (n > 0 || kb >= 8) { const LAS unsigned char* kt = F.lds + (kb < 8 ? sprev : scur) * SLOT + (16 * (kb & 7) + fr) * ATT_PITCH + fq * 16;
                    bf16x8 ka[4];
#pragma unroll
                    for (int ks = 0; ks < 4; ++ks) ka[ks] = *(const LAS bf16x8*)(kt + ks * 64);
#pragma unroll
                    for (int ks = 0; ks < 4; ++ks) s[kbi] = __builtin_amdgcn_mfma_f32_16x16x32_bf16(ka[ks], qf[ks], s[kbi], 0, 0, 0); } }
            float mx = -1.0e30f;
#pragma unroll
            for (int kbi = 0; kbi < 9; ++kbi) { const bool blk = (n > 0) || (w + kbi >= 8);
#pragma unroll
                for (int rg = 0; rg < 4; ++rg) { const bool ok = blk && (kbi == 0 ? (4 * fq + rg >= fr) : (kbi == 8 ? (4 * fq + rg <= fr) : true));
                    s[kbi][rg] = ok ? s[kbi][rg] : -1.0e30f; mx = fmaxf(mx, s[kbi][rg]); } }
            mx = fmaxf(mx, __shfl_xor(mx, 16)); mx = fmaxf(mx, __shfl_xor(mx, 32));
            float lsum = 0.f;
#pragma unroll
            for (int kbi = 0; kbi < 9; ++kbi)
#pragma unroll
                for (int rg = 0; rg < 4; ++rg) { const float pvv = __builtin_amdgcn_exp2f(s[kbi][rg] - mx); s[kbi][rg] = pvv; lsum += pvv; }
            lsum += __shfl_xor(lsum, 16); lsum += __shfl_xor(lsum, 32);
            f32x4 o[8];
#pragma unroll
            for (int db = 0; db < 8; ++db) o[db] = (f32x4){0.f, 0.f, 0.f, 0.f};
            const int trow = 4 * fq + ((lane & 15) >> 2), tcol = (lane & 3) * 8;
#pragma unroll
            for (int kk = 0; kk < 5; ++kk) { const int kba = w + 2 * kk, kbb = (kk < 4) ? kba + 1 : kba;
                if (n > 0 || kbb >= 8 || kba >= 8) {
                    v4u pw; pw.x = pk2(s[2 * kk][0], s[2 * kk][1]); pw.y = pk2(s[2 * kk][2], s[2 * kk][3]);
                    if (kk < 4) { pw.z = pk2(s[2 * kk + 1][0], s[2 * kk + 1][1]); pw.w = pk2(s[2 * kk + 1][2], s[2 * kk + 1][3]); } else { pw.z = 0u; pw.w = 0u; }
                    const bf16x8 pf = __builtin_bit_cast(bf16x8, pw);
                    const LAS unsigned char* va = F.lds + ATT_VOFF + (kba < 8 ? sprev : scur) * SLOT + (16 * (kba & 7) + trow) * ATT_PITCH + tcol;
                    const LAS unsigned char* vb = F.lds + ATT_VOFF + (kbb < 8 ? sprev : scur) * SLOT + (16 * (kbb & 7) + trow) * ATT_PITCH + tcol;
                    s16x4 lo[8], hi[8];
#pragma unroll
                    for (int db = 0; db < 8; ++db) { lo[db] = __builtin_amdgcn_ds_read_tr16_b64_v4i16((LAS s16x4*)(va + 32 * db)); hi[db] = __builtin_amdgcn_ds_read_tr16_b64_v4i16((LAS s16x4*)(vb + 32 * db)); }
#pragma unroll
                    for (int db = 0; db < 8; ++db) { const bf16x8 vf = __builtin_shufflevector(lo[db], hi[db], 0, 1, 2, 3, 4, 5, 6, 7); o[db] = __builtin_amdgcn_mfma_f32_16x16x32_bf16(vf, pf, o[db], 0, 0, 0); } } }
            const float inv = 1.0f / lsum;
            if (!FUSE) {
#pragma unroll
                for (int db = 0; db < 8; ++db) { v2u wv; wv.x = pk2(o[db][0] * inv, o[db][1] * inv); wv.y = pk2(o[db][2] * inv, o[db][3] * inv); *(v2u*)(Op + qrow * 2048 + hd * 128 + 16 * db + 4 * fq) = wv; }
                if (fq == 0) LSE[((size_t)pt * M + qrow) * 16 + hd] = mx + __builtin_amdgcn_logf(lsum);
            } else {
                const float l3 = mx + __builtin_amdgcn_logf(lsum), l1 = LSE[((size_t)0 * M + qrow) * 16 + hd], l2 = LSE[((size_t)1 * M + qrow) * 16 + hd];
                const float mm = fmaxf(l1, fmaxf(l2, l3)); const float w1r = __builtin_amdgcn_exp2f(l1 - mm), w2r = __builtin_amdgcn_exp2f(l2 - mm), w3r = __builtin_amdgcn_exp2f(l3 - mm); const float iw = 1.0f / (w1r + w2r + w3r);
                const float w1 = w1r * iw, w2 = w2r * iw, w3 = w3r * iw * inv;
                const bf16* O1 = (const bf16*)(F.ws + WS_O1); const bf16* O2 = (const bf16*)(F.ws + WS_O2); bf16* A2 = (bf16*)(F.ws + WS_A2H);
#pragma unroll
                for (int db = 0; db < 8; ++db) { const size_t oo = qrow * 2048 + hd * 128 + 16 * db + 4 * fq; const v2u a = *(const v2u*)(O1 + oo), c = *(const v2u*)(O2 + oo);
                    v2u wv; wv.x = pk2(w1 * bflo(a.x) + w2 * bflo(c.x) + w3 * o[db][0], w1 * bfhi(a.x) + w2 * bfhi(c.x) + w3 * o[db][1]); wv.y = pk2(w1 * bflo(a.y) + w2 * bflo(c.y) + w3 * o[db][2], w1 * bfhi(a.y) + w2 * bfhi(c.y) + w3 * o[db][3]);
                    *(v2u*)(A2 + qrow * 4096 + 2048 + hd * 128 + 16 * db + 4 * fq) = wv; }
            }
            __syncthreads();
            if (i + 1 < I1) { ATT_STOREBLK(nn & 1); if (nn == 0) { ATT_ZEROBLK(1); } }
        }
#undef ATT_UNIT
#undef ATT_LOADBLK
#undef ATT_STOREBLK
#undef ATT_ZEROBLK
    }
    __syncthreads();
}
constexpr int SP_WPITCH = 272, SP_VPITCH = 288, SP_VOFF = 128 * SP_WPITCH;
__device__ __forceinline__ void spatial_mfma(Frame& F, const float* wsp, const float* bsp, const float* ln_g, const float* ln_b) {
    const bf16* UV = (const bf16*)(F.ws + WS_UV); bf16* A2 = (bf16*)(F.ws + WS_A2S); const float* VST = (const float*)(F.ws + WS_VSTAT);
    LAS unsigned char* Wt = F.lds; LAS unsigned char* Vt = F.lds + SP_VOFF; LAS float* muS = (LAS float*)(F.lds + SP_VOFF + 128 * SP_VPITCH);
    LAS float* rsS = muS + 256; LAS unsigned char* Ut = F.lds + SP_VOFF + 128 * SP_VPITCH + 2048;
    const int w = F.wave, lane = F.lane, fr = lane & 15, fq = lane >> 4, tid = F.tid;
    const int trow = 4 * fq + ((lane & 15) >> 2), tcol = (lane & 3) * 8;
    const int nun = (8 * 16 * 8 - (int)blockIdx.x + F.G - 1) / F.G;
    if (nun <= 0) return;
    int gcur = -1;
    v4u pvA[4], pvB[4]; v4u puA[4], puB[4]; f32x4 pgA[4], pgB[4]; f32x4 st[8];
#define SP_PREFETCH(it_, PV_, PU_, PG_) do { const int u_ = (int)blockIdx.x + ((it_) >> 2) * F.G, g_ = u_ & 7, dq_ = (it_) & 3; const size_t r0_ = (size_t)(u_ >> 3) * 128; \
        _Pragma("unroll") for (int j = 0; j < 4; ++j) { const int c = tid + 512 * j, sr = c >> 4, ch = c & 15; PV_[j] = *(const v4u*)(UV + (r0_ + sr) * UV_LD + 4096 + g_ * 512 + dq_ * 128 + ch * 8); } \
        { const int dc = g_ * 512 + dq_ * 128 + (tid & 15) * 8; PG_[0] = *(const f32x4*)(ln_g + dc); PG_[1] = *(const f32x4*)(ln_g + dc + 4); PG_[2] = *(const f32x4*)(ln_b + dc); PG_[3] = *(const f32x4*)(ln_b + dc + 4); } \
        _Pragma("unroll") for (int j = 0; j < 4; ++j) { const int c = tid + 512 * j, sr = c >> 4, ch = c & 15; PU_[j] = *(const v4u*)(UV + (r0_ + sr) * UV_LD + g_ * 512 + dq_ * 128 + ch * 8); } } while (0)
#define SP_STATLOAD(un_) do { const int u_ = (int)blockIdx.x + (un_) * F.G; const f32x4* sp = (const f32x4*)(VST + ((size_t)(u_ >> 3) * 128 + (tid >> 2)) * 128) + (tid & 3) * 8; \
        _Pragma("unroll") for (int j = 0; j < 8; ++j) st[j] = sp[j]; } while (0)
#define SP_STATFIN(buf_) do { float s1 = 0.f, s2 = 0.f; _Pragma("unroll") for (int j = 0; j < 8; ++j) { s1 += st[j][0] + st[j][2]; s2 += st[j][1] + st[j][3]; } \
        s1 += __shfl_xor(s1, 1); s1 += __shfl_xor(s1, 2); s2 += __shfl_xor(s2, 1); s2 += __shfl_xor(s2, 2); \
        if ((tid & 3) == 0) { const float mu = s1 * (1.0f / 4096.0f), var = fmaxf(s2 * (1.0f / 4096.0f) - mu * mu, 0.f); muS[(buf_) * 128 + (tid >> 2)] = mu; rsS[(buf_) * 128 + (tid >> 2)] = rsqrtf(var + NORM_EPS); } } while (0)
    const int nit = nun * 4;
    __syncthreads();
    SP_STATLOAD(0); SP_STATFIN(0); SP_PREFETCH(0, pvA, puA, pgA); if (nit > 1) SP_PREFETCH(1, pvB, puB, pgB);
    float bias[8];
#define SP_ITER(it, PV_, PU_, PG_) do { \
        const int ui = (it) >> 2, dq = (it) & 3, u = (int)blockIdx.x + ui * F.G, g = u & 7; const size_t row0 = (size_t)(u >> 3) * 128; \
        __syncthreads(); \
        if (g != gcur) { gcur = g; \
            for (int e = tid; e < 128 * 16; e += NWAVES * 64) { const int t = e >> 4, ch = e & 15; const f32x4 a = *(const f32x4*)(wsp + (size_t)g * 16384 + t * 128 + ch * 8), c = *(const f32x4*)(wsp + (size_t)g * 16384 + t * 128 + ch * 8 + 4); \
                const int s0 = ch * 8; v4u o; o.x = pk2(s0 + 0 <= t ? a[0] : 0.f, s0 + 1 <= t ? a[1] : 0.f); o.y = pk2(s0 + 2 <= t ? a[2] : 0.f, s0 + 3 <= t ? a[3] : 0.f); \
                o.z = pk2(s0 + 4 <= t ? c[0] : 0.f, s0 + 5 <= t ? c[1] : 0.f); o.w = pk2(s0 + 6 <= t ? c[2] : 0.f, s0 + 7 <= t ? c[3] : 0.f); \
                *(LAS v4u*)(Wt + t * SP_WPITCH + ch * 16) = o; } \
            _Pragma("unroll") for (int tb = 0; tb < 8; ++tb) bias[tb] = bsp[g * 128 + 16 * tb + fr]; } \
        const int sb = ui & 1; \
        _Pragma("unroll") for (int j = 0; j < 4; ++j) { const int c = tid + 512 * j, sr = c >> 4, ch = c & 15; const v4u v = PV_[j]; const float mu = muS[sb * 128 + sr], rs = rsS[sb * 128 + sr]; \
            v4u o; o.x = pk2((bflo(v.x) - mu) * rs * PG_[0][0] + PG_[2][0], (bfhi(v.x) - mu) * rs * PG_[0][1] + PG_[2][1]); o.y = pk2((bflo(v.y) - mu) * rs * PG_[0][2] + PG_[2][2], (bfhi(v.y) - mu) * rs * PG_[0][3] + PG_[2][3]); \
            o.z = pk2((bflo(v.z) - mu) * rs * PG_[1][0] + PG_[3][0], (bfhi(v.z) - mu) * rs * PG_[1][1] + PG_[3][1]); o.w = pk2((bflo(v.w) - mu) * rs * PG_[1][2] + PG_[3][2], (bfhi(v.w) - mu) * rs * PG_[1][3] + PG_[3][3]); \
            *(LAS v4u*)(Vt + sr * SP_VPITCH + ch * 16) = o; } \
        _Pragma("unroll") for (int j = 0; j < 4; ++j) { const int c = tid + 512 * j, sr = c >> 4, ch = c & 15; *(LAS v4u*)(Ut + sr * SP_VPITCH + ch * 16) = PU_[j]; } \
        const bool newunit = (dq == 3) && (ui + 1 < nun); \
        if (newunit) SP_STATLOAD(ui + 1); \
        if ((it) + 2 < nit) SP_PREFETCH((it) + 2, PV_, PU_, PG_); \
        __syncthreads(); \
        bf16x8 vf[4]; \
        _Pragma("unroll") for (int ks = 0; ks < 4; ++ks) { const s16x4 lo = __builtin_amdgcn_ds_read_tr16_b64_v4i16((LAS s16x4*)(Vt + (32 * ks + trow) * SP_VPITCH + 32 * w + tcol)); const s16x4 hi = __builtin_amdgcn_ds_read_tr16_b64_v4i16((LAS s16x4*)(Vt + (32 * ks + 16 + trow) * SP_VPITCH + 32 * w + tcol)); \
            vf[ks] = __builtin_shufflevector(lo, hi, 0, 1, 2, 3, 4, 5, 6, 7); } \
        _Pragma("unroll") for (int tb = 0; tb < 8; ++tb) { f32x4 acc = (f32x4){0.f, 0.f, 0.f, 0.f}; \
            _Pragma("unroll") for (int ks = 0; ks < 4; ++ks) if (ks <= tb / 2) { const LAS unsigned char* wp = Wt + (16 * tb + fr) * SP_WPITCH + (32 * ks + 4 * fq) * 2; const v2u lo = *(const LAS v2u*)wp, hi = *(const LAS v2u*)(wp + 32); \
                const bf16x8 wf = __builtin_bit_cast(bf16x8, (v4u){lo.x, lo.y, hi.x, hi.y}); acc = __builtin_amdgcn_mfma_f32_16x16x32_bf16(vf[ks], wf, acc, 0, 0, 0); } \
            LAS v2u* up = (LAS v2u*)(Ut + (16 * tb + fr) * SP_VPITCH + (16 * w + 4 * fq) * 2); const v2u uu = *up; \
            const float bb = bias[tb]; v2u o; o.x = pk2(bflo(uu.x) * (acc[0] + bb), bfhi(uu.x) * (acc[1] + bb)); o.y = pk2(bflo(uu.y) * (acc[2] + bb), bfhi(uu.y) * (acc[3] + bb)); \
            *up = o; } \
        if (newunit) SP_STATFIN((ui + 1) & 1); \
        __syncthreads(); \
        _Pragma("unroll") for (int j = 0; j < 4; ++j) { const int c = tid + 512 * j, sr = c >> 4, ch = c & 15; *(v4u*)(A2 + (row0 + sr) * 4096 + g * 512 + dq * 128 + ch * 8) = *(const LAS v4u*)(Ut + sr * SP_VPITCH + ch * 16); } } while (0)
    for (int it2 = 0; it2 < nit; it2 += 2) { SP_ITER(it2, pvA, puA, pgA); if (it2 + 1 < nit) SP_ITER(it2 + 1, pvB, puB, pgB); }
#undef SP_ITER
#undef SP_PREFETCH
#undef SP_STATLOAD
#undef SP_STATFIN
    __syncthreads();
}
template <int NN_> struct StaticOrderT { int G, c;
    __device__ __forceinline__ bool next(int i, pg8::Unit& u) const { constexpr int nM = M / 256, nN = NN_, nwg = nM * nN, NX = pg8::NXCD, WG = pg8::WGM; static_assert(nwg % NX == 0 && nM % WG == 0, "whole groups");
        const int L = i * G + c; if (L >= nwg) return false; const int wgid = (L % NX) * (nwg / NX) + L / NX; constexpr int nig = WG * nN; const int gid = wgid / nig, rem = wgid % nig; u.pm = gid * WG + rem % WG; u.pn = rem / WG; return true; }
    __device__ __forceinline__ void a_ready(const pg8::Unit&) const {}
    __device__ __forceinline__ void done(const pg8::Unit&) const {} };
template <class Epi, int NN_> __device__ __forceinline__ void run_gemm(Frame& F, const void* A, const void* Bt, int Kk, const Epi& E) {
    pg8::Gemm g{(const pg8::bf16_t*)A, (const pg8::bf16_t*)Bt, M, NN_ * 256, Kk}; StaticOrderT<NN_> S; S.G = F.G; S.c = (int)blockIdx.x;
    pg8::gemm_phase<Epi, StaticOrderT<NN_>, true, true>(F.lds + RING_OFF, g, S, E); }
struct Args { const float* in[25]; float* out; unsigned char* ws; int ph_lo, ph_hi, li, pad; };
__global__ void __launch_bounds__(NWAVES * 64, 2) trunk_fwd(Args args) {
    extern __shared__ __attribute__((aligned(16))) unsigned char lds[];
    Frame F;
    F.lds = (LAS unsigned char*)lds;
    F.MISC = (volatile LAS unsigned*)(F.lds + MISC_OFF);
    F.tid = threadIdx.x; F.lane = F.tid & 63; F.wave = __builtin_amdgcn_readfirstlane(F.tid >> 6);
    F.G = gridDim.x; { const int bx = blockIdx.x; F.vcu = (F.G % 8 == 0) ? (bx % 8) * (F.G / 8) + bx / 8 : bx; }
    F.ws = args.ws; F.ctl = (gu32*)(args.ws + WS_CTL);
    for (int u = F.tid; u < (LDS_BYTES - LDSCTL_OFF) / 4; u += NWAVES * 64) ((LAS unsigned*)(F.lds + LDSCTL_OFF))[u] = 0u;
    __syncthreads();
    XcdBarrier bar; bar.bar = (unsigned*)(F.ctl + CW_BAR); bar.x = 0; bar.st = nullptr;
    if (N_LAUNCHES == 1) bar = xcd_barrier_post((unsigned*)(F.ctl + CW_BAR), F.MISC + 8);
    const int lo = args.ph_lo, hi = args.ph_hi;
#define IN(k) (lo <= (k) && (k) < hi)
#define SEAM(k) do { if (IN(k) && IN((k) + 1)) xcd_barrier(bar); } while (0)
    const float* const* in = args.in;
    unsigned char* ws = args.ws;
    float* SHIFT = (float*)(ws + WS_MODV); float* APRE = SHIFT + MODV_N; float* APOST = APRE + MODV_N;
    bf16* Hb = (bf16*)(ws + WS_H); bf16* Fb = (bf16*)(ws + WS_F); bf16* HID = (bf16*)(ws + WS_HID);
    const float* x_in = in[0]; float* xo = args.out; bf16* XB = (bf16*)(ws + WS_XB);
#define MV(l, sub) ((size_t)((l) * 3 + (sub)) * 8 * 2048)
    typedef pg8::StaticOrder SO;
#define GEMM_PHASE(EPI, Aptr, Bptr, Nn, Kk, Eobj) run_gemm<EPI, (Nn) / 256>(F, (Aptr), (Bptr), (Kk), (Eobj))
#define FFN_PHASES(P, f) \
    if (IN(P)) { pg8::EpiSwiGLU E_{HID, FF}; GEMM_PHASE(pg8::EpiSwiGLU, Hb, ws + WS_WGU + (size_t)(f) * WGU_SZ, 2 * FF, D, E_); } SEAM(P); \
    if (IN((P) + 1)) { pg8::EpiPlain E_{Fb, D}; GEMM_PHASE(pg8::EpiPlain, HID, ws + WS_WDN + (size_t)(f) * WDN_SZ, D, FF, E_); } SEAM((P) + 1);

    if (IN(0)) p0_prologue(F, in);
    SEAM(0);
    if (IN(1)) rowpass<false, true, false, false>(F, x_in, nullptr, nullptr, nullptr, APRE + MV(0, 0), SHIFT + MV(0, 0), Hb);
    SEAM(1);
    FFN_PHASES(2, 0)
    if (IN(4)) rowpass<true, true, false, true>(F, x_in, XB, Fb, APOST + MV(0, 0), APRE + MV(0, 1), SHIFT + MV(0, 1), Hb);
    SEAM(4);
    if (IN(5)) { pg8::EpiHyb E_{ws + WS_BIG, (const int*)in[2], QSCALE};
        GEMM_PHASE(pg8::EpiHyb, Hb, ws + WS_WHIN, HYB_N - 256, D, E_); dt_minigemm(F, Hb, (const bf16*)(ws + WS_WHIN) + (size_t)44 * 256 * 2048, (float*)(ws + WS_DT)); }
    SEAM(5);
    if (IN(6)) { ssd_prepass(F, in); attn_phase_mfma<0, 16, false>(F); }
    SEAM(6);
    if (IN(7)) { for (int u = blockIdx.x; u < 256; u += F.G) ssd_unit_mfma(F, u >> 5, u & 31, in); attn_phase_mfma<16, 24, true>(F); }
    SEAM(7);
    if (IN(8)) {
        LAS float* rsT = (LAS float*)(F.lds + RING_BYTES); const float* SSQ = (const float*)(ws + WS_SSQ);
        { const int nN_ = D / 256, nwg_ = (M / 256) * nN_;
          for (int i = 0; i < 16; ++i) { const int L_ = i * F.G + (int)blockIdx.x; if (L_ >= nwg_) break; const int wg_ = (L_ % 8) * (nwg_ / 8) + L_ / 8; const int pm_ = (wg_ / (8 * nN_)) * 8 + (wg_ % (8 * nN_)) % 8;
            if (F.tid < 256) { const f32x4* sp = (const f32x4*)(SSQ + (size_t)(pm_ * 256 + F.tid) * 32); float sm = 0.f;
#pragma unroll
              for (int j = 0; j < 8; ++j) { const f32x4 q = sp[j]; sm += (q[0] + q[1]) + (q[2] + q[3]); }
              rsT[i * 256 + F.tid] = rsqrtf(sm * (1.0f / 2048.0f) + NORM_EPS); } } }
        __syncthreads();
        pg8::EpiPlainMid E_{Fb, D, rsT}; GEMM_PHASE(pg8::EpiPlainMid, ws + WS_A2H, ws + WS_WHOUT, D, 4096, E_); }
    SEAM(8);
    if (IN(9)) rowpass<true, true, true, true>(F, XB, XB, Fb, APOST + MV(0, 1), APRE + MV(0, 2), SHIFT + MV(0, 2), Hb);
    SEAM(9);
    FFN_PHASES(10, 1)
    if (IN(12)) rowpass<true, true, true, true>(F, XB, XB, Fb, APOST + MV(0, 2), APRE + MV(1, 0), SHIFT + MV(1, 0), Hb);
    SEAM(12);
    FFN_PHASES(13, 2)
    if (IN(15)) rowpass<true, true, true, true>(F, XB, XB, Fb, APOST + MV(1, 0), APRE + MV(1, 1), SHIFT + MV(1, 1), Hb);
    SEAM(15);
    if (IN(16)) { pg8::EpiGelu E_{(bf16*)(ws + WS_UV), UV_LD, in[19], (float*)(ws + WS_VSTAT), 16}; GEMM_PHASE(pg8::EpiGelu, Hb, ws + WS_WSIN, 8192, D, E_); }
    SEAM(16);
    if (IN(17)) spatial_mfma(F, in[22], in[23], in[20], in[21]);
    SEAM(17);
    if (IN(18)) { pg8::EpiPlain E_{Fb, D}; GEMM_PHASE(pg8::EpiPlain, ws + WS_A2S, ws + WS_WSOUT, D, 4096, E_); }
    SEAM(18);
    if (IN(19)) rowpass<true, true, true, true>(F, XB, XB, Fb, APOST + MV(1, 1), APRE + MV(1, 2), SHIFT + MV(1, 2), Hb);
    SEAM(19);
    FFN_PHASES(20, 3)
    if (IN(22)) rowpass<true, false, true, false>(F, XB, xo, Fb, APOST + MV(1, 2), nullptr, nullptr, nullptr);
#undef IN
#undef SEAM
}

extern "C" void kernel_launch(void* const* d_in, const int* in_sizes, int n_in, void* d_out, int out_size, void* d_ws, size_t ws_size, hipStream_t stream) {
    static int grid = 0;
    if (grid == 0) {
        if (n_in != 25 || in_sizes[0] != M * D || out_size != M * D || ws_size < WS_END) { fprintf(stderr, "kernel_launch: unexpected shapes (n_in %d, in0 %d, out %d, ws %zu < %zu); nothing launched\n", n_in, n_in > 0 ? in_sizes[0] : -1, out_size, ws_size, (size_t)WS_END); grid = -1; return; }
        int dev = 0, cus = 0, per_cu = 0;
        if (hipGetDevice(&dev) != hipSuccess || hipDeviceGetAttribute(&cus, hipDeviceAttributeMultiprocessorCount, dev) != hipSuccess) { grid = -1; return; }
        if (hipFuncSetAttribute((const void*)trunk_fwd, hipFuncAttributeMaxDynamicSharedMemorySize, LDS_BYTES) != hipSuccess) { fprintf(stderr, "kernel_launch: hipFuncSetAttribute failed\n"); grid = -1; return; }
        if (hipOccupancyMaxActiveBlocksPerMultiprocessor(&per_cu, (const void*)trunk_fwd, NWAVES * 64, LDS_BYTES) != hipSuccess || per_cu < 1) { fprintf(stderr, "kernel_launch: occupancy query reports %d blocks per CU\n", per_cu); }
        (void)hipGetLastError();
        grid = cus;
    }
    if (grid < 0) return;
    if (hipMemsetAsync((char*)d_ws + WS_CTL, 0, CTL_ZERO_BYTES, stream) != hipSuccess) return;
    Args a{};
    for (int i = 0; i < 25; ++i) a.in[i] = (const float*)d_in[i];
    a.out = (float*)d_out; a.ws = (unsigned char*)d_ws; a.pad = 0;
    for (int li = 0; li < N_LAUNCHES; ++li) {
        a.ph_lo = (N_LAUNCHES == 1) ? 0 : li; a.ph_hi = (N_LAUNCHES == 1) ? NPHASE : li + 1; a.li = li;
        hipLaunchKernelGGL(trunk_fwd, dim3(grid), dim3(NWAVES * 64), LDS_BYTES, stream, a);
    }
}
```

```cpp
#include <hip/hip_runtime.h>
#include <cstdio>
#include <cstdint>
#ifndef MK_N_LAUNCHES
#define MK_N_LAUNCHES 1
#endif
namespace pg8 {
#define PG8_LAS __attribute__((address_space(3)))
typedef unsigned short bf16_t;
typedef short bf16x8 __attribute__((ext_vector_type(8)));
typedef float f32x4 __attribute__((ext_vector_type(4)));
typedef unsigned u32x4 __attribute__((ext_vector_type(4)));
constexpr int BM = 256, BK = 64, HALF = 128, HTB = HALF * BK * 2  , STAGE_BYTES = 8 * HTB, NXCD = 8, WGM = 8;

__host__ __device__ __forceinline__ int lds_byte(int r, int c) { const int st = (r >> 4) * 2 + (c >> 5), rr = r & 15, cc = c & 31, ob = rr * 64 + cc * 2; return st * 1024 + (ob ^ (((ob >> 9) & 1) << 5)); }
__host__ __device__ __forceinline__ void stage_rc(int b, int& R, int& C) { const int st = b / 1024, sb = b % 1024, swz = sb ^ (((sb >> 9) & 1) << 5); R = (st >> 1) * 16 + swz / 64; C = (st & 1) * 32 + (swz % 64) / 2; }
__host__ __device__ __forceinline__ int perm32(int rho) { const int n = rho >> 4, i = rho & 15; return 8 * (i >> 2) + 4 * n + (i & 3); }

struct Unit { int pm, pn; };
struct Gemm { const bf16_t* A; const bf16_t* Bt; int M, N, K; };

struct StaticOrder {
    int nM, nN, nwg, G, c;
    __host__ __device__ void init(int M, int N, int G_, int c_) { nM = M / BM; nN = N / BM; nwg = nM * nN; G = G_; c = c_; }
    __host__ __device__ bool next(int i, Unit& u) const {
        const long L = (long)i * G + c; if (L >= nwg) return false;
        int wgid = (int)L; { const int q = nwg / NXCD, r = nwg % NXCD, xcd = wgid % NXCD, off = wgid / NXCD; wgid = (xcd < r ? xcd * (q + 1) : r * (q + 1) + (xcd - r) * q) + off; }
        const int nig = WGM * nN, gid = wgid / nig, fm = gid * WGM, gsz = (nM - fm) < WGM ? (nM - fm) : WGM;
        u.pm = fm + ((wgid % nig) % gsz); u.pn = (wgid % nig) / gsz; return true;
    }
    __device__ __forceinline__ void a_ready(const Unit&) const {}
    __device__ __forceinline__ void done(const Unit&) const {}
};

__device__ __forceinline__ unsigned cvt_pk_bf16(float lo, float hi) { unsigned r; asm volatile("v_cvt_pk_bf16_f32 %0, %1, %2" : "=v"(r) : "v"(lo), "v"(hi)); return r; }
__device__ __forceinline__ float fast_silu(float x) { return x * __builtin_amdgcn_rcpf(1.0f + __builtin_amdgcn_exp2f(-1.4426950408889634f * x)); }
__device__ __forceinline__ float fast_gelu_tanh(float x) { const float u = x * (0.7978845608028654f + 0.035677408136300125f * x * x); return x * __builtin_amdgcn_rcpf(1.0f + __builtin_amdgcn_exp2f(-2.8853900817779268f * u)); }

typedef float f32x2 __attribute__((ext_vector_type(2)));
__device__ __forceinline__ f32x2 gelu_tanh_pk(f32x2 x) { const f32x2 xx = x * x; const f32x2 t = x * (xx * (-0.1029432395800235f) + (-2.302208198144325f));
    f32x2 e; e.x = __builtin_amdgcn_exp2f(t.x); e.y = __builtin_amdgcn_exp2f(t.y); const f32x2 d = e + 1.0f; f32x2 r; r.x = __builtin_amdgcn_rcpf(d.x); r.y = __builtin_amdgcn_rcpf(d.y); return x * r; }
__device__ __forceinline__ f32x2 swiglu_pk(f32x2 g, f32x2 u) { const f32x2 t = g * (-1.4426950408889634f); f32x2 e; e.x = __builtin_amdgcn_exp2f(t.x); e.y = __builtin_amdgcn_exp2f(t.y); const f32x2 d = e + 1.0f;
    f32x2 r; r.x = __builtin_amdgcn_rcpf(d.x); r.y = __builtin_amdgcn_rcpf(d.y); return (g * u) * r; }
struct EpiPlain {
    static constexpr bool PERM = true, AFTER_DRAIN = false, MIDHOOK = false; static constexpr int NST = 16;
    bf16_t* O; int ldc;
    __device__ __forceinline__ void operator()(const f32x4 (&acc)[2][2][4][2], const Unit& u, int wr, int wc, int fr, int fq) const {
        const int row0 = u.pm * BM + wr * 64 + fr, col0 = u.pn * BM + wc * 32 + 8 * fq;
#pragma unroll
        for (int ai = 0; ai < 2; ++ai)
#pragma unroll
            for (int m = 0; m < 4; ++m) { bf16_t* rowp = O + (size_t)(row0 + ai * HALF + m * 16) * ldc + col0;
#pragma unroll
                for (int bj = 0; bj < 2; ++bj) { const f32x4 v0 = acc[ai][bj][m][0], v1 = acc[ai][bj][m][1];
                    u32x4 w; w.x = cvt_pk_bf16(v0[0], v0[1]); w.y = cvt_pk_bf16(v0[2], v0[3]); w.z = cvt_pk_bf16(v1[0], v1[1]); w.w = cvt_pk_bf16(v1[2], v1[3]);
                    *(u32x4*)(rowp + bj * HALF) = w; } }
    }
};
struct EpiPlainMid {
    static constexpr bool PERM = true, AFTER_DRAIN = false, MIDHOOK = true; static constexpr int NST = 16;
    bf16_t* O; int ldc; const PG8_LAS float* rs;
    __device__ __forceinline__ void operator()(const f32x4 (&acc)[2][2][4][2], const Unit& u, int wr, int wc, int fr, int fq) const {
        const int row0 = u.pm * BM + wr * 64 + fr, col0 = u.pn * BM + wc * 32 + 8 * fq;
#pragma unroll
        for (int ai = 0; ai < 2; ++ai)
#pragma unroll
            for (int m = 0; m < 4; ++m) { bf16_t* rowp = O + (size_t)(row0 + ai * HALF + m * 16) * ldc + col0;
#pragma unroll
                for (int bj = 0; bj < 2; ++bj) { const f32x4 v0 = acc[ai][bj][m][0], v1 = acc[ai][bj][m][1];
                    u32x4 w; w.x = cvt_pk_bf16(v0[0], v0[1]); w.y = cvt_pk_bf16(v0[2], v0[3]); w.z = cvt_pk_bf16(v1[0], v1[1]); w.w = cvt_pk_bf16(v1[2], v1[3]);
                    *(u32x4*)(rowp + bj * HALF) = w; } }
    }
    __device__ __forceinline__ void mid(f32x4 (&acc)[2][2][4][2], int ui, int wr, int fr) const {
#pragma unroll
        for (int ai = 0; ai < 2; ++ai)
#pragma unroll
            for (int m = 0; m < 4; ++m) { const float r = rs[ui * BM + ai * HALF + wr * 64 + m * 16 + fr];
#pragma unroll
                for (int bj = 0; bj < 2; ++bj)
#pragma unroll
                    for (int n = 0; n < 2; ++n) acc[ai][bj][m][n] = acc[ai][bj][m][n] * r; }
    }
};
struct EpiSwiGLU {
    static constexpr bool PERM = true, AFTER_DRAIN = false, MIDHOOK = false; static constexpr int NST = 8;
    bf16_t* O; int ldc;
    __device__ __forceinline__ void operator()(const f32x4 (&acc)[2][2][4][2], const Unit& u, int wr, int wc, int fr, int fq) const {
        const int row0 = u.pm * BM + wr * 64 + fr, col0 = u.pn * HALF + wc * 32 + 8 * fq;
#pragma unroll
        for (int ai = 0; ai < 2; ++ai)
#pragma unroll
            for (int m = 0; m < 4; ++m) { bf16_t* rowp = O + (size_t)(row0 + ai * HALF + m * 16) * ldc + col0;
                const f32x4 g0 = acc[ai][0][m][0], g1 = acc[ai][0][m][1], u0 = acc[ai][1][m][0], u1 = acc[ai][1][m][1];
                const f32x2 ha = swiglu_pk((f32x2){g0[0], g0[1]}, (f32x2){u0[0], u0[1]}), hb = swiglu_pk((f32x2){g0[2], g0[3]}, (f32x2){u0[2], u0[3]}), hc = swiglu_pk((f32x2){g1[0], g1[1]}, (f32x2){u1[0], u1[1]}), hd = swiglu_pk((f32x2){g1[2], g1[3]}, (f32x2){u1[2], u1[3]});
                u32x4 w; w.x = cvt_pk_bf16(ha.x, ha.y); w.y = cvt_pk_bf16(hb.x, hb.y); w.z = cvt_pk_bf16(hc.x, hc.y); w.w = cvt_pk_bf16(hd.x, hd.y);
                *(u32x4*)(rowp) = w; }
    }
};
struct EpiGelu {
    static constexpr bool PERM = true, AFTER_DRAIN = false, MIDHOOK = false; static constexpr int NST = 16;
    bf16_t* O; int ldc; const float* bias; float* stats; int stat_tile0;
    __device__ __forceinline__ void operator()(const f32x4 (&acc)[2][2][4][2], const Unit& u, int wr, int wc, int fr, int fq) const {
        const int row0 = u.pm * BM + wr * 64 + fr, col0 = u.pn * BM + wc * 32 + 8 * fq;
        f32x4 bv[2][2];
#pragma unroll
        for (int bj = 0; bj < 2; ++bj)
#pragma unroll
            for (int n = 0; n < 2; ++n) bv[bj][n] = *(const f32x4*)(bias + col0 + bj * HALF + 4 * n);
        const bool st = u.pn >= stat_tile0;
#pragma unroll
        for (int ai = 0; ai < 2; ++ai)
#pragma unroll
            for (int m = 0; m < 4; ++m) { const int r = row0 + ai * HALF + m * 16; bf16_t* rowp = O + (size_t)r * ldc + col0; f32x2 a1 = (f32x2){0.f, 0.f}, a2 = a1;
#pragma unroll
                for (int bj = 0; bj < 2; ++bj) { const f32x4 v0 = acc[ai][bj][m][0] + bv[bj][0], v1 = acc[ai][bj][m][1] + bv[bj][1];
                    const f32x2 g0 = gelu_tanh_pk((f32x2){v0[0], v0[1]}), g1 = gelu_tanh_pk((f32x2){v0[2], v0[3]}), g2 = gelu_tanh_pk((f32x2){v1[0], v1[1]}), g3 = gelu_tanh_pk((f32x2){v1[2], v1[3]});
                    a1 += (g0 + g1) + (g2 + g3); a2 += (g0 * g0 + g1 * g1) + (g2 * g2 + g3 * g3);
                    u32x4 w; w.x = cvt_pk_bf16(g0.x, g0.y); w.y = cvt_pk_bf16(g1.x, g1.y); w.z = cvt_pk_bf16(g2.x, g2.y); w.w = cvt_pk_bf16(g3.x, g3.y);
                    *(u32x4*)(rowp + bj * HALF) = w; }
                float s1 = a1.x + a1.y, s2 = a2.x + a2.y;
                if (st) { s1 += __shfl_xor(s1, 16); s1 += __shfl_xor(s1, 32); s2 += __shfl_xor(s2, 16); s2 += __shfl_xor(s2, 32);
                    if (fq == 0) { float* sp = stats + ((size_t)r * 64 + (u.pn - stat_tile0) * 4 + wc) * 2; sp[0] = s1; sp[1] = s2; } } }
    }
};
struct EpiHyb {
    static constexpr bool PERM = true, AFTER_DRAIN = false, MIDHOOK = false; static constexpr int NST = 16;
    unsigned char* big; const int* pos;
    float qscale;
    __device__ __forceinline__ void operator()(const f32x4 (&acc)[2][2][4][2], const Unit& u, int wr, int wc, int fr, int fq) const {
        const int row0 = u.pm * BM + wr * 64 + fr; const int pn = u.pn;
        if (pn < 20 || (pn >= 36 && pn < 44)) {
            const size_t boff = pn < 8 ? (size_t)0 : (pn < 20 ? ((size_t)363 << 20) : ((size_t)192 << 20)); const int ldc = (pn >= 8 && pn < 20) ? 3072 : 2048, ct = pn < 8 ? pn : (pn < 20 ? pn - 8 : pn - 36);
            bf16_t* base = (bf16_t*)(big + boff);
            const int col0 = ct * BM + wc * 32 + 8 * fq;
#pragma unroll
            for (int ai = 0; ai < 2; ++ai)
#pragma unroll
                for (int m = 0; m < 4; ++m) { bf16_t* rowp = base + (size_t)(row0 + ai * HALF + m * 16) * ldc + col0;
#pragma unroll
                    for (int bj = 0; bj < 2; ++bj) { const f32x4 v0 = acc[ai][bj][m][0], v1 = acc[ai][bj][m][1];
                        u32x4 w; w.x = cvt_pk_bf16(v0[0], v0[1]); w.y = cvt_pk_bf16(v0[2], v0[3]); w.z = cvt_pk_bf16(v1[0], v1[1]); w.w = cvt_pk_bf16(v1[2], v1[3]);
                        *(u32x4*)(rowp + bj * HALF) = w; } }
        } else if (pn < 36) {
            const bool isq = pn < 28; bf16_t* base = (bf16_t*)(big + (isq ? ((size_t)64 << 20) : ((size_t)128 << 20))); const int t = isq ? pn - 20 : pn - 28; const float sc = isq ? qscale : 1.0f;
            const int cp = wc * 32 + 8 * fq;
            const int head = 2 * t + (cp >> 6), jj = cp & 63;
            float fr8[8];
#pragma unroll
            for (int e = 0; e < 8; ++e) fr8[e] = exp2f(-(float)(jj + e) * (13.287712379549449f / 64.0f)) * 0.15915494309189535f;
            int pv[8];
#pragma unroll
            for (int ai = 0; ai < 2; ++ai)
#pragma unroll
                for (int m = 0; m < 4; ++m) pv[ai * 4 + m] = pos[row0 + ai * HALF + m * 16];
#pragma unroll
            for (int ai = 0; ai < 2; ++ai)
#pragma unroll
                for (int m = 0; m < 4; ++m) { const int r = row0 + ai * HALF + m * 16; const float pf = (float)pv[ai * 4 + m];
                    float cs[8], sn[8];
#pragma unroll
                    for (int e = 0; e < 8; ++e) { const float rev = __builtin_amdgcn_fractf(pf * fr8[e]); cs[e] = __builtin_amdgcn_cosf(rev); sn[e] = __builtin_amdgcn_sinf(rev); }
                    float o1[8], o2[8];
#pragma unroll
                    for (int n = 0; n < 2; ++n)
#pragma unroll
                        for (int j = 0; j < 4; ++j) { const float t1 = acc[ai][0][m][n][j], t2 = acc[ai][1][m][n][j]; const int e = 4 * n + j;
                            o1[e] = (t1 * cs[e] - t2 * sn[e]) * sc; o2[e] = (t2 * cs[e] + t1 * sn[e]) * sc; }
                    bf16_t* rowp = base + (size_t)r * 2048 + head * 128 + jj;
                    u32x4 w; w.x = cvt_pk_bf16(o1[0], o1[1]); w.y = cvt_pk_bf16(o1[2], o1[3]); w.z = cvt_pk_bf16(o1[4], o1[5]); w.w = cvt_pk_bf16(o1[6], o1[7]);
                    *(u32x4*)(rowp) = w;
                    w.x = cvt_pk_bf16(o2[0], o2[1]); w.y = cvt_pk_bf16(o2[2], o2[3]); w.z = cvt_pk_bf16(o2[4], o2[5]); w.w = cvt_pk_bf16(o2[6], o2[7]);
                    *(u32x4*)(rowp + 64) = w; }
        }
    }
};
template <class Epi, class Sched, bool ALIGN_EPI = false, bool SP2 = false>
__device__ __forceinline__ void gemm_phase(PG8_LAS unsigned char* lds, const Gemm g, const Sched& S, const Epi& E) {
    const int tid = threadIdx.x, wid = __builtin_amdgcn_readfirstlane(tid >> 6), lane = tid & 63, wr = wid >> 2, wc = wid & 3, fr = lane & 15, fq = lane >> 4;
    const int K = g.K, nt = K / BK;
    unsigned voffA[2], voffB[2];
#pragma unroll
    for (int i = 0; i < 2; ++i) { int R, C; stage_rc(tid * 16 + i * 8192, R, C); const int Rb = Epi::PERM ? ((R & ~31) + perm32(R & 31)) : R;
        voffA[i] = (unsigned)(R * K + C) * 2u; voffB[i] = (unsigned)(Rb * K + C) * 2u; }
    const size_t kstep = (size_t)(BK * 2);
    const size_t hstep = (size_t)HALF * K * 2;
    const size_t tstep = 2 * hstep;
    const unsigned ldsw = (unsigned)wid * 1024u;
    const int aoff = lds_byte(wr * 64 + fr, fq * 8), boff = lds_byte(wc * 32 + fr, fq * 8);
#define PG8_SA(b, h) (((b) * 2 + (h)) * HTB)
#define PG8_SB(b, h) ((4 + (b) * 2 + (h)) * HTB)
#define PG8_STAGE(bufoff, gbase, voff) do { _Pragma("unroll") for (int _i = 0; _i < 2; ++_i) \
        __builtin_amdgcn_global_load_lds((const unsigned*)((const char*)(gbase) + (voff)[_i]), (PG8_LAS unsigned*)(lds + (bufoff) + ldsw + _i * 8192), 16, 0, 0); } while (0)
#define PG8_LDA(dst, b, h) do { _Pragma("unroll") for (int m = 0; m < 4; ++m) _Pragma("unroll") for (int k = 0; k < 2; ++k) dst[m][k] = *(const PG8_LAS bf16x8*)(lds + PG8_SA(b, h) + aoff + m * 2048 + k * 1024); } while (0)
#define PG8_LDB(dst, b, h) do { _Pragma("unroll") for (int n = 0; n < 2; ++n) _Pragma("unroll") for (int k = 0; k < 2; ++k) dst[n][k] = *(const PG8_LAS bf16x8*)(lds + PG8_SB(b, h) + boff + n * 2048 + k * 1024); } while (0)
#define PG8_MMA(ai, bj, At, Bt) do { __builtin_amdgcn_s_setprio(1); _Pragma("unroll") for (int m = 0; m < 4; ++m) _Pragma("unroll") for (int n = 0; n < 2; ++n) _Pragma("unroll") for (int k = 0; k < 2; ++k) \
        acc[ai][bj][m][n] = __builtin_amdgcn_mfma_f32_16x16x32_bf16(Bt[n][k], At[m][k], acc[ai][bj][m][n], 0, 0, 0); __builtin_amdgcn_s_setprio(0); } while (0)
#define PG8_WAIT_V(n) asm volatile("s_waitcnt vmcnt(" #n ")" ::: "memory")
#define PG8_WAIT_L(n) asm volatile("s_waitcnt lgkmcnt(" #n ")" ::: "memory")
#define PG8_BAR __builtin_amdgcn_s_barrier()
#define PG8_SCHED __builtin_amdgcn_sched_barrier(0)
    Unit cur, nxt; int ui = 0;
    if (!S.next(0, cur)) return;
    f32x4 acc[2][2][4][2];
#pragma unroll
    for (int a = 0; a < 2; ++a)
#pragma unroll
        for (int b = 0; b < 2; ++b)
#pragma unroll
            for (int m = 0; m < 4; ++m)
#pragma unroll
                for (int n = 0; n < 2; ++n) acc[a][b][m][n] = (f32x4){0.f, 0.f, 0.f, 0.f};
    bf16x8 At[4][2], B0[2][2], B1[2][2];
    const char* cA = (const char*)g.A + (size_t)cur.pm * tstep; const char* cB = (const char*)g.Bt + (size_t)cur.pn * tstep;
    S.a_ready(cur);
    if constexpr (SP2) {
        PG8_STAGE(PG8_SB(0, 0), cB, voffB); PG8_STAGE(PG8_SB(0, 1), cB + hstep, voffB); PG8_STAGE(PG8_SA(0, 0), cA, voffA); PG8_STAGE(PG8_SA(0, 1), cA + hstep, voffA);
        if (wr == 1) PG8_BAR;
        PG8_WAIT_V(2); PG8_BAR;
        PG8_STAGE(PG8_SB(1, 0), cB + kstep, voffB); PG8_STAGE(PG8_SA(1, 0), cA + kstep, voffA); PG8_STAGE(PG8_SB(1, 1), cB + hstep + kstep, voffB);
        PG8_WAIT_V(6); PG8_BAR;
    } else {
        PG8_STAGE(PG8_SB(0, 0), cB, voffB); PG8_STAGE(PG8_SA(0, 0), cA, voffA); PG8_STAGE(PG8_SB(0, 1), cB + hstep, voffB); PG8_STAGE(PG8_SA(0, 1), cA + hstep, voffA);
        if (wr == 1) PG8_BAR;
        PG8_WAIT_V(4); PG8_BAR;
        PG8_STAGE(PG8_SB(1, 0), cB + kstep, voffB); PG8_STAGE(PG8_SA(1, 0), cA + kstep, voffA); PG8_STAGE(PG8_SB(1, 1), cB + hstep + kstep, voffB);
        PG8_WAIT_V(6); PG8_BAR;
    }
    for (;;) {
        const bool has_next = S.next(ui + 1, nxt);
        const char* nA = has_next ? (const char*)g.A + (size_t)nxt.pm * tstep : cA; const char* nB = has_next ? (const char*)g.Bt + (size_t)nxt.pn * tstep : cB;
        for (int t = 0; t < nt; t += 2) {
            const bool last = (t == nt - 2);
            const char* a1 = cA + (size_t)(t + 1) * kstep;
            const char* a2 = last ? nA : cA + (size_t)(t + 2) * kstep; const char* b2 = last ? nB : cB + (size_t)(t + 2) * kstep;
            const char* a3 = a2 + kstep; const char* b3 = b2 + kstep;
            if constexpr (Epi::MIDHOOK) { if (t == (nt >> 1)) E.mid(acc, ui, wr, fr); }
            if (last && has_next) S.a_ready(nxt);
            if constexpr (SP2) {
            PG8_LDB(B0, 0, 0); PG8_LDB(B1, 0, 1); PG8_SCHED; PG8_LDA(At, 0, 0); PG8_STAGE(PG8_SA(1, 1), a1 + hstep, voffA);
            PG8_WAIT_V(8); PG8_WAIT_L(0); PG8_BAR; PG8_MMA(0, 0, At, B0); PG8_MMA(0, 1, At, B1); PG8_BAR; PG8_SCHED;
            PG8_LDA(At, 0, 1); PG8_STAGE(PG8_SB(0, 0), b2, voffB); PG8_STAGE(PG8_SB(0, 1), b2 + hstep, voffB); PG8_STAGE(PG8_SA(0, 0), a2, voffA);
            PG8_WAIT_V(8); PG8_WAIT_L(0); PG8_BAR; PG8_MMA(1, 0, At, B0); PG8_MMA(1, 1, At, B1); PG8_BAR; PG8_SCHED;
            PG8_LDB(B0, 1, 0); PG8_LDB(B1, 1, 1); PG8_SCHED; PG8_LDA(At, 1, 0); PG8_STAGE(PG8_SA(0, 1), a2 + hstep, voffA);
            PG8_WAIT_V(8); PG8_WAIT_L(0); PG8_BAR; PG8_MMA(0, 0, At, B0); PG8_MMA(0, 1, At, B1); PG8_BAR; PG8_SCHED;
            PG8_LDA(At, 1, 1); PG8_STAGE(PG8_SB(1, 0), b3, voffB); PG8_STAGE(PG8_SB(1, 1), b3 + hstep, voffB); PG8_STAGE(PG8_SA(1, 0), a3, voffA);
            PG8_WAIT_V(8); PG8_WAIT_L(0); PG8_BAR; PG8_MMA(1, 0, At, B0); PG8_MMA(1, 1, At, B1); PG8_BAR; PG8_SCHED;
            } else {
            PG8_LDB(B0, 0, 0); PG8_SCHED; PG8_LDA(At, 0, 0); PG8_STAGE(PG8_SA(1, 1), a1 + hstep, voffA);
            PG8_WAIT_L(8); PG8_BAR; PG8_WAIT_L(0); PG8_MMA(0, 0, At, B0); PG8_BAR; PG8_SCHED;
            PG8_LDB(B1, 0, 1); PG8_STAGE(PG8_SB(0, 0), b2, voffB);
            PG8_BAR; PG8_WAIT_L(0); PG8_MMA(0, 1, At, B1); PG8_BAR;
            PG8_LDA(At, 0, 1); PG8_STAGE(PG8_SA(0, 0), a2, voffA);
            PG8_BAR; PG8_WAIT_L(0); PG8_MMA(1, 0, At, B0); PG8_BAR; PG8_SCHED;
            PG8_STAGE(PG8_SB(0, 1), b2 + hstep, voffB);
            PG8_WAIT_V(6); PG8_BAR; PG8_MMA(1, 1, At, B1); PG8_BAR;
            PG8_LDB(B0, 1, 0); PG8_SCHED; PG8_LDA(At, 1, 0); PG8_STAGE(PG8_SA(0, 1), a2 + hstep, voffA);
            PG8_WAIT_L(8); PG8_BAR; PG8_WAIT_L(0); PG8_MMA(0, 0, At, B0); PG8_BAR; PG8_SCHED;
            PG8_LDB(B1, 1, 1); PG8_STAGE(PG8_SB(1, 0), b3, voffB);
            PG8_BAR; PG8_WAIT_L(0); PG8_MMA(0, 1, At, B1); PG8_BAR;
            PG8_LDA(At, 1, 1); PG8_STAGE(PG8_SA(1, 0), a3, voffA);
            PG8_BAR; PG8_WAIT_L(0); PG8_MMA(1, 0, At, B0); PG8_BAR; PG8_SCHED;
            PG8_STAGE(PG8_SB(1, 1), b3 + hstep, voffB);
            PG8_WAIT_V(6); PG8_BAR; PG8_MMA(1, 1, At, B1); PG8_BAR;
            }
        }
        if constexpr (ALIGN_EPI) { if (wr == 0) PG8_BAR; }
        if constexpr (!Epi::AFTER_DRAIN) { E(acc, cur, wr, wc, fr, fq); S.done(cur); }
        if (!has_next) break;
#pragma unroll
        for (int a = 0; a < 2; ++a)
#pragma unroll
            for (int b = 0; b < 2; ++b)
#pragma unroll
                for (int m = 0; m < 4; ++m)
#pragma unroll
                    for (int n = 0; n < 2; ++n) acc[a][b][m][n] = (f32x4){0.f, 0.f, 0.f, 0.f};
        cur = nxt; cA = nA; cB = nB; ++ui;
        if constexpr (ALIGN_EPI) { if (wr == 1) PG8_BAR; }
    }
    PG8_WAIT_V(0);
    if constexpr (!ALIGN_EPI) { if (wr == 0) PG8_BAR; }
    PG8_BAR;
    if constexpr (Epi::AFTER_DRAIN) { E.fused(acc, cur, wr, wc, fr, fq, lds, wid, lane); S.done(cur); }
#undef PG8_SA
#undef PG8_SB
#undef PG8_STAGE
#undef PG8_LDA
#undef PG8_LDB
#undef PG8_MMA
#undef PG8_WAIT_V
#undef PG8_WAIT_L
#undef PG8_BAR
#undef PG8_SCHED
}
}

constexpr int NWAVES = 8;
constexpr int NPHASE = 23;
constexpr int N_LAUNCHES = MK_N_LAUNCHES;
static_assert(N_LAUNCHES == 1 || N_LAUNCHES == NPHASE, "MK_N_LAUNCHES is 1 or NPHASE");
constexpr int BATCH = 8, SEQ = 2048, D = 2048, FF = 5632, M = BATCH * SEQ;
constexpr int HYB_N = 45 * 256;
constexpr float NORM_EPS = 1e-6f;
constexpr float QSCALE = 0.08838834764831845f * 1.4426950408889634f;

constexpr size_t MiB = 1u << 20;
constexpr size_t WS_CTL = 0, CTL_ZERO_BYTES = 1 * MiB;
constexpr size_t WS_MODV = 1 * MiB;
constexpr size_t MODV_N = 2 * 3 * 8 * 2048;
constexpr size_t WS_ROPE = 3 * MiB;
constexpr size_t WS_WGU = 11 * MiB, WGU_SZ = 44 * MiB;
constexpr size_t WS_WDN = 187 * MiB, WDN_SZ = 22 * MiB;
constexpr size_t WS_WHIN = 275 * MiB, WS_WHOUT = 320 * MiB, WS_WSIN = 336 * MiB, WS_WSOUT = 368 * MiB;
constexpr size_t WS_H = 384 * MiB, WS_F = 448 * MiB, WS_BIG = 512 * MiB;
constexpr size_t WS_HID = WS_BIG;
constexpr size_t WS_Z = WS_BIG, WS_Q = WS_BIG + 64 * MiB, WS_K = WS_BIG + 128 * MiB, WS_V = WS_BIG + 192 * MiB, WS_XBCC = WS_BIG + 256 * MiB, WS_LSE = WS_BIG + 352 * MiB;
constexpr size_t WS_DT = WS_BIG + 355 * MiB, WS_DTS = WS_BIG + 357 * MiB, WS_ACS = WS_BIG + 359 * MiB, WS_SSQ = WS_BIG + 361 * MiB, WS_XBC = WS_BIG + 363 * MiB, WS_A2H = WS_XBC;
constexpr size_t WS_O1 = WS_F, WS_O2 = WS_H;
constexpr int UV_LD = 8192 + 256;
constexpr size_t WS_UV = WS_BIG, WS_A2S = WS_BIG + 264 * MiB, WS_VSTAT = WS_BIG + 392 * MiB;
constexpr size_t WS_XB = WS_BIG + 522 * MiB;
constexpr size_t WS_END = WS_XB + 64 * MiB;
static_assert(WS_A2H + 128 * MiB <= WS_XB && WS_LSE + 3 * MiB <= WS_DT && WS_A2S + 128 * MiB <= WS_VSTAT && WS_VSTAT + 8 * MiB <= WS_XB && WS_UV + (size_t)M * UV_LD * 2 <= WS_A2S && WS_HID + (size_t)M * FF * 2 <= WS_END, "ws map");
constexpr int CW_TMO = 0, CW_CODE = 1, CW_BAR = 4096;

constexpr int RING_OFF = 0, RING_BYTES = 131072;
constexpr int LDS_BYTES = 163840;
constexpr int LDSCTL_OFF = LDS_BYTES - 512, MISC_OFF = LDSCTL_OFF + 320;

#define GAS __attribute__((address_space(1)))
#define LAS __attribute__((address_space(3)))
typedef unsigned short bf16;
typedef unsigned v4u __attribute__((ext_vector_type(4)));
typedef unsigned v2u __attribute__((ext_vector_type(2)));
typedef float f32x4 __attribute__((ext_vector_type(4)));
typedef GAS unsigned gu32;
typedef short bf16x8 __attribute__((ext_vector_type(8)));
typedef short s16x4 __attribute__((ext_vector_type(4)));
#define RLX_AGENT __ATOMIC_RELAXED, __HIP_MEMORY_SCOPE_AGENT
#define LDS_WAIT() asm volatile("s_waitcnt lgkmcnt(0)" ::: "memory")
#define VM_WAIT() asm volatile("s_waitcnt vmcnt(0)" ::: "memory")
#define WG_SYNC_LDS() asm volatile("s_waitcnt lgkmcnt(0)\n\ts_barrier" ::: "memory")
__device__ __forceinline__ float bf2f(unsigned short b) { return __uint_as_float(((unsigned)b) << 16); }
__device__ __forceinline__ float bflo(unsigned w) { return __uint_as_float(w << 16); }
__device__ __forceinline__ float bfhi(unsigned w) { return __uint_as_float(w & 0xffff0000u); }
__device__ __forceinline__ unsigned pk2(float lo, float hi) { return pg8::cvt_pk_bf16(lo, hi); }
__device__ __forceinline__ unsigned short f2bf(float f) { return (unsigned short)(pg8::cvt_pk_bf16(f, 0.f) & 0xffffu); }
__device__ __forceinline__ float wave_sum(float v) {
#pragma unroll
    for (int o = 1; o < 64; o <<= 1) v += __shfl_xor(v, o);
    return v;
}
__device__ __forceinline__ float wave_max(float v) {
#pragma unroll
    for (int o = 1; o < 64; o <<= 1) v = fmaxf(v, __shfl_xor(v, o));
    return v;
}
__device__ __forceinline__ float silu_f(float x) { return x / (1.0f + __expf(-x)); }

#define XB_TMO      128
#define XB_XCNT(j)  (256  + 64 * (j))
#define XB_XSUB(j)  (1280 + 64 * (j))
#define XB_XGEN(j)  (2304 + 64 * (j))
#define XB_TOP      3328
#define XB_TOPGEN   3392
#define XCD_BAR_WORDS 3456
#define XB_SPIN_CAP (1u << 18)

__device__ __forceinline__ unsigned xb_ld(unsigned* p)              { return __hip_atomic_load(p, __ATOMIC_RELAXED, __HIP_MEMORY_SCOPE_AGENT); }
__device__ __forceinline__ unsigned xb_add(unsigned* p, unsigned v) { return __hip_atomic_fetch_add(p, v, __ATOMIC_RELAXED, __HIP_MEMORY_SCOPE_AGENT); }
__device__ __forceinline__ unsigned xb_xcc_id() { return (unsigned)__builtin_amdgcn_s_getreg((3 << 11) | 20) & 0xFu; }
#define XB_SPIN(cond, bar) do { unsigned _sp = 0; while (cond) { __builtin_amdgcn_s_sleep(1); \
    if ((++_sp & 255u) == 0u) { if (xb_ld(&(bar)[XB_TMO])) break; if (_sp > XB_SPIN_CAP) { atomicAdd(&(bar)[XB_TMO], 1u); break; } } } } while (0)

struct XcdBarrier {
    unsigned* bar; unsigned x;
    volatile LAS unsigned* st;
};

__device__ __forceinline__ XcdBarrier xcd_barrier_post(unsigned* bar, volatile LAS unsigned* st) {
    XcdBarrier b; b.bar = bar; b.x = xb_xcc_id(); b.st = st;
    if (threadIdx.x == 0) (void)xb_add(&bar[XB_XCNT(b.x)], 1u);
    return b;
}
__device__ __forceinline__ void xcd_barrier_complete(unsigned* bar, unsigned x, unsigned& nloc, unsigned& nx) {
    const unsigned G = gridDim.x * gridDim.y * gridDim.z;
    unsigned sum, cnt, mine, sp = 0u;
    for (;;) {
        sum = 0u; cnt = 0u; mine = 0u;
#pragma unroll
        for (unsigned j = 0; j < 16; ++j) { const unsigned c = xb_ld(&bar[XB_XCNT(j)]); sum += c; cnt += (c > 0u) ? 1u : 0u; mine = (j == x) ? c : mine; }
        if (sum == G) break;
        __builtin_amdgcn_s_sleep(1);
        if ((++sp & 255u) == 0u) { if (xb_ld(&bar[XB_TMO])) break; if (sp > XB_SPIN_CAP) { atomicAdd(&bar[XB_TMO], 1u); break; } }
    }
    nloc = mine > 0u ? mine : 1u; nx = cnt > 0u ? cnt : 1u;
}

__device__ __forceinline__ void xcd_barrier(const XcdBarrier& b) {
    asm volatile("s_waitcnt vmcnt(0)" ::: "memory");
    __syncthreads();
    if (threadIdx.x == 0) {
        unsigned* bar = b.bar;
        __builtin_amdgcn_s_waitcnt(0);
        unsigned nloc = b.st[0], nx = b.st[1];
        if (nloc == 0u) { xcd_barrier_complete(bar, b.x, nloc, nx); b.st[0] = nloc; b.st[1] = nx; }
        const unsigned old = xb_add(&bar[XB_XSUB(b.x)], 1u);
        const unsigned gen = old / nloc;
        if (old + 1u == (gen + 1u) * nloc) {
            __builtin_amdgcn_fence(__ATOMIC_RELEASE, "agent");
            asm volatile("s_waitcnt vmcnt(0)" ::: "memory");
            const unsigned og = xb_add(&bar[XB_TOP], 1u);
            const unsigned tg = og / nx;
            if (og + 1u == (tg + 1u) * nx) xb_add(&bar[XB_TOPGEN], 1u);
            else XB_SPIN(xb_ld(&bar[XB_TOPGEN]) == tg, bar);
            __builtin_amdgcn_fence(__ATOMIC_ACQUIRE, "agent");
            xb_add(&bar[XB_XGEN(b.x)], 1u);
            asm volatile("s_waitcnt vmcnt(0)" ::: "memory");
        } else {
            XB_SPIN(xb_ld(&bar[XB_XGEN(b.x)]) == gen, bar);
            __builtin_amdgcn_fence(__ATOMIC_ACQUIRE, "agent");
            asm volatile("s_waitcnt vmcnt(0)" ::: "memory");
        }
    }
    __syncthreads();
}

template <class Hook> __device__ __forceinline__ void xcd_barrier_h(const XcdBarrier& b, const Hook& hook) {
    asm volatile("s_waitcnt vmcnt(0)" ::: "memory");
    __syncthreads();
    if (threadIdx.x == 0) {
        unsigned* bar = b.bar;
        __builtin_amdgcn_s_waitcnt(0);
        unsigned nloc = b.st[0], nx = b.st[1];
        if (nloc == 0u) { xcd_barrier_complete(bar, b.x, nloc, nx); b.st[0] = nloc; b.st[1] = nx; }
        const unsigned old = xb_add(&bar[XB_XSUB(b.x)], 1u);
        const unsigned gen = old / nloc;
        if (old + 1u == (gen + 1u) * nloc) {
            __builtin_amdgcn_fence(__ATOMIC_RELEASE, "agent");
            asm volatile("s_waitcnt vmcnt(0)" ::: "memory");
            const unsigned og = xb_add(&bar[XB_TOP], 1u);
            const unsigned tg = og / nx;
            if (og + 1u == (tg + 1u) * nx) xb_add(&bar[XB_TOPGEN], 1u);
            else XB_SPIN(xb_ld(&bar[XB_TOPGEN]) == tg, bar);
            __builtin_amdgcn_fence(__ATOMIC_ACQUIRE, "agent");
            xb_add(&bar[XB_XGEN(b.x)], 1u);
            asm volatile("s_waitcnt vmcnt(0)" ::: "memory");
        } else {
            XB_SPIN(xb_ld(&bar[XB_XGEN(b.x)]) == gen, bar);
            __builtin_amdgcn_fence(__ATOMIC_ACQUIRE, "agent");
            asm volatile("s_waitcnt vmcnt(0)" ::: "memory");
        }
    } else hook();
    WG_SYNC_LDS();
}

struct Frame {
    LAS unsigned char* lds;
    volatile LAS unsigned* MISC;
    gu32* ctl;
    int tid, lane, wave;
    int vcu, G;
    unsigned char* ws;
};

__device__ __forceinline__ void transpose_item(const float* W, int N, int K, bf16* WT, int k0, int n0, int drow0, LAS float* scr, int lane, const float* kscale = nullptr) {
    float tv[32];
#pragma unroll
    for (int i = 0; i < 32; ++i) { const int kk = 2 * i + (lane >> 5); tv[i] = W[(size_t)(k0 + kk) * N + n0 + (lane & 31)]; }
#pragma unroll
    for (int i = 0; i < 32; ++i) { const int kk = 2 * i + (lane >> 5); scr[kk * 33 + (lane & 31)] = kscale ? tv[i] * kscale[k0 + kk] : tv[i]; }
    LDS_WAIT(); asm volatile("" ::: "memory");
    const int c = lane & 7;
#pragma unroll
    for (int j = 0; j < 4; ++j) { const int n = (lane >> 3) + 8 * j; const LAS float* s = scr + (8 * c) * 33 + n;
        v4u o; o.x = pk2(s[0 * 33], s[1 * 33]); o.y = pk2(s[2 * 33], s[3 * 33]); o.z = pk2(s[4 * 33], s[5 * 33]); o.w = pk2(s[6 * 33], s[7 * 33]);
        *(GAS v4u*)(WT + (size_t)(drow0 + n) * K + k0 + 8 * c) = o; }
    LDS_WAIT(); asm volatile("" ::: "memory");
}
__device__ __forceinline__ void transpose_item64(const float* W, int N, int K, bf16* WT, int k0, int n0, int drowA, int drowB, LAS float* scr, int lane, const float* kscale = nullptr) {
    float tv[64];
#pragma unroll
    for (int i = 0; i < 64; ++i) tv[i] = W[(size_t)(k0 + i) * N + n0 + lane];
#pragma unroll
    for (int i = 0; i < 64; ++i) scr[i * 65 + lane] = kscale ? tv[i] * kscale[k0 + i] : tv[i];
    LDS_WAIT(); asm volatile("" ::: "memory");
    const int c = lane & 7;
#pragma unroll
    for (int j = 0; j < 8; ++j) { const int n = (lane >> 3) + 8 * j; const LAS float* s = scr + (8 * c) * 65 + n;
        v4u o; o.x = pk2(s[0 * 65], s[1 * 65]); o.y = pk2(s[2 * 65], s[3 * 65]); o.z = pk2(s[4 * 65], s[5 * 65]); o.w = pk2(s[6 * 65], s[7 * 65]);
        const int drow = n < 32 ? drowA + n : drowB + (n - 32);
        *(GAS v4u*)(WT + (size_t)drow * K + k0 + 8 * c) = o; }
    LDS_WAIT(); asm volatile("" ::: "memory");
}
constexpr int I_F = 32 * 88, I_HIN = 32 * 176, I_DT = 32, I_O = 64 * 32, I_SIN = 32 * 128;
constexpr int NITEMS = 12 * I_F + I_HIN + I_DT + I_O + I_SIN + I_O;
constexpr int DEF_SEAMS = 20, DEF_PER_SEAM = 256 * 7, DEF_N = DEF_SEAMS * DEF_PER_SEAM, DEF_HIN0 = 3328;
constexpr int DEF_P_HOUT = I_HIN - DEF_HIN0, DEF_P_F12 = DEF_P_HOUT + I_O, DEF_P_SIN = DEF_P_F12 + 6 * I_F, DEF_P_SOUT = DEF_P_SIN + I_SIN, DEF_P_F3 = DEF_P_SOUT + I_O;
static_assert(DEF_P_F3 + 3 * I_F == DEF_N, "deferred list fills the barriers exactly");
constexpr int def_last_seam(int end_pos) { return (end_pos - 1) / DEF_PER_SEAM; }
static_assert(def_last_seam(DEF_P_HOUT) + 2 <= 5 && def_last_seam(DEF_P_F12) + 2 <= 8 && def_last_seam(DEF_P_F12 + 2 * I_F) + 2 <= 10 && def_last_seam(DEF_P_F12 + 3 * I_F) + 2 <= 11 &&
              def_last_seam(DEF_P_F12 + 5 * I_F) + 2 <= 13 && def_last_seam(DEF_P_SIN) + 2 <= 14 && def_last_seam(DEF_P_SOUT) + 2 <= 16 && def_last_seam(DEF_P_F3) + 2 <= 18 &&
              def_last_seam(DEF_P_F3 + 2 * I_F) + 2 <= 20 && def_last_seam(DEF_N) + 2 <= 21, "every deferred weight is visible by the phase that first reads it");
__device__ __forceinline__ bool defer_on(const Frame& F) { return N_LAUNCHES == 1 && F.G == 256; }
__device__ __forceinline__ int hyb_in_row(int n0) {
    if (n0 < 5120) return n0;
    if (n0 < 5152) return 44 * 256;
    int c, base;
    if (n0 < 7200) { c = n0 - 5152; base = 20 * 256; } else if (n0 < 9248) { c = n0 - 7200; base = 28 * 256; } else return 36 * 256 + (n0 - 9248);
    const int head = c >> 7, d = c & 127, half = d >> 6, j = d & 63;
    return base + (head >> 1) * 256 + half * 128 + (head & 1) * 64 + j;
}
__device__ __forceinline__ void p0_prologue(Frame& F, const float* const* in) {
    const float* c_in = in[1]; const float* w_mod = in[3]; const float* b_mod = in[4]; const float* norm_pre = in[5]; const float* norm_post = in[6];
    float* SHIFT = (float*)(F.ws + WS_MODV); float* APRE = SHIFT + MODV_N; float* APOST = APRE + MODV_N;
    {
        LAS float* ca = (LAS float*)(F.lds);
        LAS float* red = (LAS float*)(F.lds + 65536);
        for (int e = F.tid; e < 8 * 2048; e += NWAVES * 64) { const int b = e >> 11, k = e & 2047; const float v = c_in[e]; ca[k * 8 + b] = v / (1.0f + expf(-v)); }
        __syncthreads();
        for (int item = blockIdx.x; item < 256; item += F.G) {
            const int n0 = item * 144, l = n0 / 18432, nl = n0 % 18432; const bool act = F.lane < 36;
            f32x4 acc[8];
#pragma unroll
            for (int b = 0; b < 8; ++b) acc[b] = (f32x4){0.f, 0.f, 0.f, 0.f};
            const float* wp = w_mod + ((size_t)l * 2048 + F.wave * 256) * 18432 + nl + 4 * (act ? F.lane : 0);
#pragma unroll 8
            for (int k = 0; k < 256; ++k) { const f32x4 wv = *(const f32x4*)(wp + (size_t)k * 18432); const LAS f32x4* cp = (const LAS f32x4*)(ca + (F.wave * 256 + k) * 8); const f32x4 c0 = cp[0], c1 = cp[1];
                acc[0] += wv * c0[0]; acc[1] += wv * c0[1]; acc[2] += wv * c0[2]; acc[3] += wv * c0[3]; acc[4] += wv * c1[0]; acc[5] += wv * c1[1]; acc[6] += wv * c1[2]; acc[7] += wv * c1[3]; }
            if (act) {
#pragma unroll
                for (int b = 0; b < 8; ++b) *(LAS f32x4*)(red + (F.wave * 8 + b) * 144 + 4 * F.lane) = acc[b]; }
            __syncthreads();
            for (int e = F.tid; e < 8 * 144; e += NWAVES * 64) { const int b = e / 144, cl = e % 144, n = nl + cl; float s = b_mod[l * 18432 + n];
#pragma unroll
                for (int w = 0; w < 8; ++w) s += red[(w * 8 + b) * 144 + cl];
                const int sub = n / 6144, kind = (n % 6144) >> 11, d = n & 2047; const size_t idx = ((size_t)(l * 3 + sub) * 8 + b) * 2048 + d; const int gi = (l * 3 + sub) * 2048 + d;
                if (kind == 0) SHIFT[idx] = s; else if (kind == 1) APRE[idx] = norm_pre[gi] * (1.0f + s); else APOST[idx] = (sub == 1 ? 1.0f : 0.5f) * (1.0f + s) * norm_post[gi]; }
            __syncthreads();
        }
    }
    {
        __syncthreads();
        LAS float* scr = (LAS float*)(F.lds + F.wave * 16640);
        const int gw = F.vcu * NWAVES + F.wave, NGW = F.G * NWAVES;
        const bool defer = defer_on(F);
        for (int it = gw; it < NITEMS; it += NGW) {
            int r = NITEMS - 1 - it;
            if (r < 12 * I_F) {
                if (defer && r >= 3 * I_F) continue;
                const int f = r / (3 * I_F), which = (r / I_F) % 3, q = r % I_F;
                if (which < 2) { const int kb = q / 88, n0 = (q % 88) * 64; const float* W = (which == 0 ? in[7] : in[8]) + (size_t)f * 2048 * 5632; const int dr = (n0 >> 7) * 256 + which * 128 + (n0 & 127);
                    transpose_item64(W, 5632, 2048, (bf16*)(F.ws + WS_WGU + f * WGU_SZ), kb * 64, n0, dr, dr + 32, scr, F.lane); }
                else { const int kb = q / 32, n0 = (q % 32) * 64; transpose_item64(in[9] + (size_t)f * 5632 * 2048, 2048, 5632, (bf16*)(F.ws + WS_WDN + f * WDN_SZ), kb * 64, n0, n0, n0 + 32, scr, F.lane); }
                continue; }
            r -= 12 * I_F;
            if (r < I_HIN) { if (defer && r >= DEF_HIN0) continue; const int kb = r / 176, p_ = r % 176, n0 = p_ < 80 ? 64 * p_ : 5152 + 64 * (p_ - 80);
                transpose_item64(in[10], 11296, 2048, (bf16*)(F.ws + WS_WHIN), kb * 64, n0, hyb_in_row(n0), hyb_in_row(n0 + 32), scr, F.lane); continue; } r -= I_HIN;
            if (r < I_DT) { transpose_item(in[10], 11296, 2048, (bf16*)(F.ws + WS_WHIN), r * 64, 5120, hyb_in_row(5120), scr, F.lane); continue; } r -= I_DT;
            if (r < I_O) { if (defer) continue; const int kb = r / 32, n0 = (r % 32) * 64; transpose_item64(in[17], 2048, 4096, (bf16*)(F.ws + WS_WHOUT), kb * 64, n0, n0, n0 + 32, scr, F.lane, kb < 32 ? in[16] : nullptr); continue; } r -= I_O;
            if (r < I_SIN) { if (defer) continue; const int kb = r / 128, n0 = (r % 128) * 64; transpose_item64(in[18], 8192, 2048, (bf16*)(F.ws + WS_WSIN), kb * 64, n0, n0, n0 + 32, scr, F.lane); continue; } r -= I_SIN;
            { if (defer) continue; const int kb = r / 32, n0 = (r % 32) * 64; transpose_item64(in[24], 2048, 4096, (bf16*)(F.ws + WS_WSOUT), kb * 64, n0, n0, n0 + 32, scr, F.lane); }
        }
    }
}

__device__ __forceinline__ void deferred_item(Frame& F, const float* const* in, int dx) {
    LAS float* scr = (LAS float*)(F.lds + F.wave * 16640);
    const float* W; bf16* WT; const float* ks = nullptr; int N, K, kb, n0, drA, drB;
    if (dx < DEF_P_HOUT) { const int p = DEF_HIN0 + dx, p_ = p % 176; kb = p / 176; n0 = p_ < 80 ? 64 * p_ : 5152 + 64 * (p_ - 80); W = in[10]; N = 11296; K = 2048; WT = (bf16*)(F.ws + WS_WHIN); drA = hyb_in_row(n0); drB = hyb_in_row(n0 + 32); }
    else if (dx < DEF_P_F12) { const int i = dx - DEF_P_HOUT; kb = i / 32; n0 = (i % 32) * 64; W = in[17]; N = 2048; K = 4096; WT = (bf16*)(F.ws + WS_WHOUT); drA = n0; drB = n0 + 32; ks = kb < 32 ? in[16] : nullptr; }
    else if (dx >= DEF_P_SIN && dx < DEF_P_SOUT) { const int i = dx - DEF_P_SIN; kb = i / 128; n0 = (i % 128) * 64; W = in[18]; N = 8192; K = 2048; WT = (bf16*)(F.ws + WS_WSIN); drA = n0; drB = n0 + 32; }
    else if (dx >= DEF_P_SOUT && dx < DEF_P_F3) { const int i = dx - DEF_P_SOUT; kb = i / 32; n0 = (i % 32) * 64; W = in[24]; N = 2048; K = 4096; WT = (bf16*)(F.ws + WS_WSOUT); drA = n0; drB = n0 + 32; }
    else { const int r = dx < DEF_P_SIN ? 3 * I_F + (dx - DEF_P_F12) : 9 * I_F + (dx - DEF_P_F3), f = r / (3 * I_F), which = (r / I_F) % 3, q = r % I_F;
        if (which < 2) { kb = q / 88; n0 = (q % 88) * 64; W = (which == 0 ? in[7] : in[8]) + (size_t)f * 2048 * 5632; N = 5632; K = 2048; WT = (bf16*)(F.ws + WS_WGU + f * WGU_SZ); drA = (n0 >> 7) * 256 + which * 128 + (n0 & 127); }
        else { kb = q / 32; n0 = (q % 32) * 64; W = in[9] + (size_t)f * 5632 * 2048; N = 2048; K = 5632; WT = (bf16*)(F.ws + WS_WDN + f * WDN_SZ); drA = n0; }
        drB = drA + 32; }
    transpose_item64(W, N, K, WT, kb * 64, n0, drA, drB, scr, F.lane, ks);
}

template <bool HAS_F, bool HAS_H, bool XIN16, bool XOUT16>
__device__ __forceinline__ void rowpass(Frame& F, const void* xin_, void* xout_, const bf16* fbuf, const float* apost, const float* apre, const float* shift, bf16* hout) {
    const int gw = F.vcu * NWAVES + F.wave;
    for (int rb = gw; rb < M / 8; rb += F.G * NWAVES) {
        const int r0 = rb * 8, b = r0 >> 11;
        f32x4 ap[8], pr[8], sh[8];
#pragma unroll
        for (int j = 0; j < 8; ++j) { const int c = 4 * F.lane + 256 * j;
            if (HAS_F) ap[j] = *(const f32x4*)(apost + b * 2048 + c);
            if (HAS_H) { pr[j] = *(const f32x4*)(apre + b * 2048 + c); sh[j] = *(const f32x4*)(shift + b * 2048 + c); } }
        v2u nx16[8], nf[8]; f32x4 nx32[8];
#define RP_LOAD(rrow) do { const size_t r_ = (size_t)(r0 + (rrow)); _Pragma("unroll") for (int j = 0; j < 8; ++j) { const size_t o_ = r_ * D + 4 * F.lane + 256 * j; \
            if (XIN16) nx16[j] = *(const v2u*)((const bf16*)xin_ + o_); else nx32[j] = *(const f32x4*)((const float*)xin_ + o_); \
            if (HAS_F) nf[j] = *(const v2u*)(fbuf + o_); } } while (0)
        RP_LOAD(0);
        for (int rr = 0; rr < 8; ++rr) {
            const size_t r = (size_t)(r0 + rr);
            f32x4 xv[8]; v2u fw[8];
#pragma unroll
            for (int j = 0; j < 8; ++j) { if (XIN16) { const v2u w = nx16[j]; xv[j] = (f32x4){bflo(w.x), bfhi(w.x), bflo(w.y), bfhi(w.y)}; } else xv[j] = nx32[j]; if (HAS_F) fw[j] = nf[j]; }
            if (rr + 1 < 8) RP_LOAD(rr + 1);
            if (HAS_F) {
                f32x4 fv[8]; float ss = 0.f;
#pragma unroll
                for (int j = 0; j < 8; ++j) { const v2u w = fw[j]; fv[j] = (f32x4){bflo(w.x), bfhi(w.x), bflo(w.y), bfhi(w.y)};
                    ss += (fv[j][0] * fv[j][0] + fv[j][1] * fv[j][1]) + (fv[j][2] * fv[j][2] + fv[j][3] * fv[j][3]); }
                const float rstd = rsqrtf(wave_sum(ss) * (1.0f / D) + NORM_EPS);
#pragma unroll
                for (int j = 0; j < 8; ++j) { xv[j] = xv[j] + ap[j] * fv[j] * rstd; const size_t o = r * D + 4 * F.lane + 256 * j;
                    if (XOUT16) { v2u w; w.x = pk2(xv[j][0], xv[j][1]); w.y = pk2(xv[j][2], xv[j][3]); *(v2u*)((bf16*)xout_ + o) = w; } else *(f32x4*)((float*)xout_ + o) = xv[j]; }
            }
            if (HAS_H) {
                float ss = 0.f;
#pragma unroll
                for (int j = 0; j < 8; ++j) ss += (xv[j][0] * xv[j][0] + xv[j][1] * xv[j][1]) + (xv[j][2] * xv[j][2] + xv[j][3] * xv[j][3]);
                const float rstd = rsqrtf(wave_sum(ss) * (1.0f / D) + NORM_EPS);
#pragma unroll
                for (int j = 0; j < 8; ++j) { const f32x4 hv = xv[j] * rstd * pr[j] + sh[j]; v2u w; w.x = pk2(hv[0], hv[1]); w.y = pk2(hv[2], hv[3]); *(v2u*)(hout + r * D + 4 * F.lane + 256 * j) = w; }
            }
        }
    }
}

#undef RP_LOAD
__device__ __forceinline__ void dt_minigemm(Frame& F, const bf16* Hb, const bf16* Wt, float* DT) {
    constexpr int WP = 4112;
    __syncthreads();
    for (int e = F.tid; e < 32 * 256; e += NWAVES * 64) { const int row = e >> 8, c16 = e & 255; *(LAS v4u*)(F.lds + row * WP + c16 * 16) = *(const v4u*)(Wt + (size_t)row * 2048 + c16 * 8); }
    __syncthreads();
    const int fr = F.lane & 15, fq = F.lane >> 4;
    if (F.wave < 4)
    for (int rb = F.vcu * 4 + F.wave; rb < M / 16; rb += F.G * 4) {
        const bf16* ap = Hb + (size_t)(16 * rb + fr) * 2048 + 8 * fq; const LAS unsigned char* b0 = F.lds + fr * WP + fq * 16; const LAS unsigned char* b1 = b0 + 16 * WP;
        f32x4 a0 = (f32x4){0.f, 0.f, 0.f, 0.f}, a1 = a0;
#pragma unroll 8
        for (int ks = 0; ks < 64; ++ks) { const bf16x8 av = *(const bf16x8*)(ap + 32 * ks), w0 = *(const LAS bf16x8*)(b0 + 64 * ks), w1 = *(const LAS bf16x8*)(b1 + 64 * ks);
            a0 = __builtin_amdgcn_mfma_f32_16x16x32_bf16(av, w0, a0, 0, 0, 0); a1 = __builtin_amdgcn_mfma_f32_16x16x32_bf16(av, w1, a1, 0, 0, 0); }
#pragma unroll
        for (int rg = 0; rg < 4; ++rg) { DT[(size_t)(16 * rb + 4 * fq + rg) * 32 + fr] = a0[rg]; DT[(size_t)(16 * rb + 4 * fq + rg) * 32 + 16 + fr] = a1[rg]; }
    }
}

__device__ __forceinline__ void ssd_prepass(Frame& F, const float* const* in) {
    const float* conv_w = in[11]; const float* conv_b = in[12];
    const bf16* __restrict__ XBC = (const bf16*)(F.ws + WS_XBC); bf16* __restrict__ XC = (bf16*)(F.ws + WS_XBCC); const float* DT = (const float*)(F.ws + WS_DT); float* DTS = (float*)(F.ws + WS_DTS); float* ACS = (float*)(F.ws + WS_ACS);
    const int gw = F.vcu * NWAVES + F.wave;
    for (int it = gw; it < 1536 + 128; it += F.G * NWAVES) {
        if (it < 1536) {
            const int b = it / 192, rem = it % 192, slab = rem >> 5, run = rem & 31, ch = slab * 512 + 8 * F.lane, t0 = run * 64;
            float wt[4][8], bs[8];
#pragma unroll
            for (int j = 0; j < 4; ++j) { const f32x4 a = *(const f32x4*)(conv_w + j * 3072 + ch), c = *(const f32x4*)(conv_w + j * 3072 + ch + 4); wt[j][0] = a[0]; wt[j][1] = a[1]; wt[j][2] = a[2]; wt[j][3] = a[3]; wt[j][4] = c[0]; wt[j][5] = c[1]; wt[j][6] = c[2]; wt[j][7] = c[3]; }
            { const f32x4 a = *(const f32x4*)(conv_b + ch), c = *(const f32x4*)(conv_b + ch + 4); bs[0] = a[0]; bs[1] = a[1]; bs[2] = a[2]; bs[3] = a[3]; bs[4] = c[0]; bs[5] = c[1]; bs[6] = c[2]; bs[7] = c[3]; }
            const bf16* src = XBC + (size_t)(b * 2048 + t0) * 3072 + ch; bf16* dst = XC + (size_t)(b * 2048 + t0) * 3072 + ch;
            pg8::f32x2 wv[4][4], bv2[4], q0[4], q1[4], q2[4];
#pragma unroll
            for (int e = 0; e < 4; ++e) { bv2[e] = (pg8::f32x2){bs[2 * e], bs[2 * e + 1]};
#pragma unroll
                for (int j = 0; j < 4; ++j) wv[j][e] = (pg8::f32x2){wt[j][2 * e], wt[j][2 * e + 1]}; }
#define CV_UNPACK(dst, v) do { dst[0] = (pg8::f32x2){bflo((v).x), bfhi((v).x)}; dst[1] = (pg8::f32x2){bflo((v).y), bfhi((v).y)}; dst[2] = (pg8::f32x2){bflo((v).z), bfhi((v).z)}; dst[3] = (pg8::f32x2){bflo((v).w), bfhi((v).w)}; } while (0)
            { v4u h0 = (v4u){0u, 0u, 0u, 0u}, h1 = h0, h2 = h0;
              if (t0 > 0) { h0 = *(const v4u*)(src - 3 * 3072); h1 = *(const v4u*)(src - 2 * 3072); h2 = *(const v4u*)(src - 3072); }
              CV_UNPACK(q0, h0); CV_UNPACK(q1, h1); CV_UNPACK(q2, h2); }
            v4u rn[8];
#pragma unroll
            for (int i = 0; i < 8; ++i) rn[i] = *(const v4u*)(src + (size_t)i * 3072);
            for (int tb = 0; tb < 64; tb += 8) {
                v4u rw[8];
#pragma unroll
                for (int i = 0; i < 8; ++i) rw[i] = rn[i];
                if (tb + 8 < 64) {
#pragma unroll
                    for (int i = 0; i < 8; ++i) rn[i] = *(const v4u*)(src + (size_t)(tb + 8 + i) * 3072); }
#pragma unroll
                for (int i = 0; i < 8; ++i) { pg8::f32x2 q3[4]; CV_UNPACK(q3, rw[i]); pg8::f32x2 o[4];
#pragma unroll
                    for (int e = 0; e < 4; ++e) { const pg8::f32x2 c = bv2[e] + wv[0][e] * q0[e] + wv[1][e] * q1[e] + wv[2][e] * q2[e] + wv[3][e] * q3[e];
                        const pg8::f32x2 t = c * (-1.4426950408889634f); pg8::f32x2 ex; ex.x = __builtin_amdgcn_exp2f(t.x); ex.y = __builtin_amdgcn_exp2f(t.y); const pg8::f32x2 d = ex + 1.0f;
                        pg8::f32x2 r; r.x = __builtin_amdgcn_rcpf(d.x); r.y = __builtin_amdgcn_rcpf(d.y); o[e] = c * r; q0[e] = q1[e]; q1[e] = q2[e]; q2[e] = q3[e]; }
                    v4u ov; ov.x = pk2(o[0].x, o[0].y); ov.y = pk2(o[1].x, o[1].y); ov.z = pk2(o[2].x, o[2].y); ov.w = pk2(o[3].x, o[3].y);
                    *(v4u*)(dst + (size_t)(tb + i) * 3072) = ov; }
            }
#undef CV_UNPACK
        } else {
            const int bc = it - 1536, h = F.lane & 31; const size_t row0 = (size_t)bc * 128;
            if (F.lane < 32) { const float a = -expf(in[14][h]), dtb = in[13][h]; float cum = 0.f;
                float rnx[16];
#pragma unroll
                for (int i = 0; i < 16; ++i) rnx[i] = DT[(row0 + i) * 32 + h];
                for (int l0 = 0; l0 < 128; l0 += 16) { float rv[16];
#pragma unroll
                    for (int i = 0; i < 16; ++i) rv[i] = rnx[i];
                    if (l0 + 16 < 128) {
#pragma unroll
                        for (int i = 0; i < 16; ++i) rnx[i] = DT[(row0 + l0 + 16 + i) * 32 + h]; }
#pragma unroll
                    for (int i = 0; i < 16; ++i) { const float raw = rv[i] + dtb; const float dt = fmaxf(raw, 0.f) + __logf(1.0f + __expf(-fabsf(raw))); cum += a * dt; DTS[(row0 + l0 + i) * 32 + h] = dt; ACS[(row0 + l0 + i) * 32 + h] = cum; } } }
        }
    }
}
constexpr int SS_BP = 288, SS_CP = 272, SS_XP = 160;
constexpr int SS_BM = 0, SS_CM = 128 * SS_BP, SS_XR = SS_CM + 128 * SS_CP, SS_XW = SS_XR + 128 * SS_XP, SS_ST = SS_XW + 128 * SS_XP, SS_ACS = SS_ST + 128 * SS_XP, SS_DT = SS_ACS + 512;
static_assert(SS_DT + 512 <= LDSCTL_OFF, "ssd LDS map");
__device__ __forceinline__ bf16x8 ld_perm(const LAS unsigned char* p) { const v2u lo = *(const LAS v2u*)p, hi = *(const LAS v2u*)(p + 32); return __builtin_bit_cast(bf16x8, (v4u){lo.x, lo.y, hi.x, hi.y}); }
__device__ __forceinline__ bf16x8 ld_tr2(const LAS unsigned char* p, int pitch16) { const s16x4 lo = __builtin_amdgcn_ds_read_tr16_b64_v4i16((LAS s16x4*)p); const s16x4 hi = __builtin_amdgcn_ds_read_tr16_b64_v4i16((LAS s16x4*)(p + pitch16)); return __builtin_shufflevector(lo, hi, 0, 1, 2, 3, 4, 5, 6, 7); }
__device__ __forceinline__ void ssd_unit_mfma(Frame& F, int b, int h, const float* const* in) {
    const bf16* XC = (const bf16*)(F.ws + WS_XBCC); const float* DTS = (const float*)(F.ws + WS_DTS); const float* ACS = (const float*)(F.ws + WS_ACS); const bf16* Z = (const bf16*)(F.ws + WS_Z); bf16* A2 = (bf16*)(F.ws + WS_A2H); float* SSQ = (float*)(F.ws + WS_SSQ);
    LAS unsigned char* Bm = F.lds + SS_BM; LAS unsigned char* Cm = F.lds + SS_CM; LAS unsigned char* Xr = F.lds + SS_XR; LAS unsigned char* Xw = F.lds + SS_XW; LAS unsigned char* ST = F.lds + SS_ST;
    LAS float* acsS = (LAS float*)(F.lds + SS_ACS); LAS float* dtS = (LAS float*)(F.lds + SS_DT);
    const int w = F.wave, lane = F.lane, fr = lane & 15, fq = lane >> 4, tid = F.tid, g = h >> 3;
    const int trow = 4 * fq + ((lane & 15) >> 2), tcol = (lane & 3) * 8;
    const float dsk = in[15][h];
    f32x4 S[4];
#pragma unroll
    for (int i = 0; i < 4; ++i) S[i] = (f32x4){0.f, 0.f, 0.f, 0.f};
    v4u pfb[4], pfc[4], pfx[2]; float pdt[2], pacs[2], pacsL = 0.f, pdtl = 0.f, pacsl = 0.f;
    const unsigned vo_bc = (unsigned)((tid >> 4) * 3072 + (tid & 15) * 8) * 2u, vo_x = (unsigned)((tid >> 3) * 3072 + (tid & 7) * 8) * 2u, vo_d = (unsigned)((tid >> 3) * 32) * 4u, vo_t = (unsigned)(tid * 32) * 4u;
#define SSD_LOAD(c) do { const size_t row0_ = (size_t)b * 2048 + (size_t)(c) * 128; \
        const unsigned char* xb_ = (const unsigned char*)(XC + row0_ * 3072 + 2048 + g * 128); const unsigned char* xx_ = (const unsigned char*)(XC + row0_ * 3072 + h * 64); \
        const unsigned char* db_ = (const unsigned char*)(DTS + row0_ * 32 + h); const unsigned char* ab_ = (const unsigned char*)(ACS + row0_ * 32 + h); \
        _Pragma("unroll") for (int j = 0; j < 4; ++j) { pfb[j] = *(const v4u*)(xb_ + (size_t)j * (32 * 3072 * 2) + vo_bc); pfc[j] = *(const v4u*)(xb_ + (size_t)j * (32 * 3072 * 2) + 1024 + vo_bc); } \
        _Pragma("unroll") for (int j = 0; j < 2; ++j) { pfx[j] = *(const v4u*)(xx_ + (size_t)j * (64 * 3072 * 2) + vo_x); pdt[j] = *(const float*)(db_ + (size_t)j * (64 * 32 * 4) + vo_d); pacs[j] = *(const float*)(ab_ + (size_t)j * (64 * 32 * 4) + vo_d); } \
        pacsL = *(const float*)(ab_ + 127 * 32 * 4); if (tid < 128) { pdtl = *(const float*)(db_ + vo_t); pacsl = *(const float*)(ab_ + vo_t); } } while (0)
    const unsigned vo_z = (unsigned)((16 * w + fr) * 2048 + 4 * fq) * 2u; v2u zv[4];
#define SSD_ZLOAD(c) do { const unsigned char* zb_ = (const unsigned char*)(Z + ((size_t)b * 2048 + (size_t)(c) * 128) * 2048 + h * 64); _Pragma("unroll") for (int pb = 0; pb < 4; ++pb) zv[pb] = *(const v2u*)(zb_ + vo_z + 32 * pb); } while (0)
    SSD_LOAD(0); SSD_ZLOAD(0);
    for (int c = 0; c < 16; ++c) {
        WG_SYNC_LDS();
#pragma unroll
        for (int i = 0; i < 4; ++i) { const int nb = 4 * (w & 1) + i, pb = w >> 1; v2u sv; sv.x = pk2(S[i][0], S[i][1]); sv.y = pk2(S[i][2], S[i][3]); *(LAS v2u*)(ST + (16 * nb + fr) * SS_XP + (16 * pb + 4 * fq) * 2) = sv; }
#pragma unroll
        for (int j = 0; j < 4; ++j) { const int cc = tid + 512 * j, l = cc >> 4, ch = cc & 15; *(LAS v4u*)(Bm + l * SS_BP + ch * 16) = pfb[j]; *(LAS v4u*)(Cm + l * SS_CP + ch * 16) = pfc[j]; }
#pragma unroll
        for (int j = 0; j < 2; ++j) { const int cc = tid + 512 * j, l = cc >> 3, ch = cc & 7; *(LAS v4u*)(Xr + l * SS_XP + ch * 16) = pfx[j]; const float wl = pdt[j] * __expf(pacsL - pacs[j]);
            v4u xw; xw.x = pk2(bflo(pfx[j].x) * wl, bfhi(pfx[j].x) * wl); xw.y = pk2(bflo(pfx[j].y) * wl, bfhi(pfx[j].y) * wl); xw.z = pk2(bflo(pfx[j].z) * wl, bfhi(pfx[j].z) * wl); xw.w = pk2(bflo(pfx[j].w) * wl, bfhi(pfx[j].w) * wl);
            *(LAS v4u*)(Xw + l * SS_XP + ch * 16) = xw; }
        if (tid < 128) { acsS[tid] = pacsl; dtS[tid] = pdtl; }
        const float eL = __expf(pacsL);
        WG_SYNC_LDS();
        const int l = 16 * w + fr;
        if (c + 1 < 16) SSD_LOAD(c + 1);
        bf16x8 cf[4];
#pragma unroll
        for (int ks = 0; ks < 4; ++ks) cf[ks] = ld_perm(Cm + l * SS_CP + (32 * ks + 4 * fq) * 2);
        f32x4 acc[4];
#pragma unroll
        for (int pb = 0; pb < 4; ++pb) acc[pb] = (f32x4){0.f, 0.f, 0.f, 0.f};
        {
            bf16x8 sfA[4], sfB[4];
#define SSD_LDS_ST(dst, ks_) _Pragma("unroll") for (int pb = 0; pb < 4; ++pb) dst[pb] = ld_tr2(ST + (32 * (ks_) + trow) * SS_XP + 32 * pb + tcol, 16 * SS_XP)
#define SSD_MMA_ST(src, ks_) _Pragma("unroll") for (int pb = 0; pb < 4; ++pb) acc[pb] = __builtin_amdgcn_mfma_f32_16x16x32_bf16(src[pb], cf[ks_], acc[pb], 0, 0, 0)
            SSD_LDS_ST(sfA, 0); SSD_MMA_ST(sfA, 0); SSD_LDS_ST(sfB, 1); SSD_MMA_ST(sfB, 1); SSD_LDS_ST(sfA, 2); SSD_MMA_ST(sfA, 2); SSD_LDS_ST(sfB, 3); SSD_MMA_ST(sfB, 3);
#undef SSD_LDS_ST
#undef SSD_MMA_ST
        }
        const float acs_l = acsS[l], el = __expf(acs_l);
#pragma unroll
        for (int pb = 0; pb < 4; ++pb) acc[pb] = acc[pb] * el;
#pragma unroll
        for (int kk = 0; kk < 4; ++kk) if (2 * kk <= w) {
            const int sa = 32 * kk, hasb = (2 * kk + 1 <= w), sb = hasb ? sa + 16 : sa;
            int lz = 0; asm volatile("" : "+v"(lz));
            const LAS unsigned char* Bz = Bm + lz; const LAS unsigned char* Xz = Xr + lz;
            bf16x8 fa[4], fb[4], xf[4];
#pragma unroll
            for (int ks = 0; ks < 4; ++ks) { fa[ks] = ld_perm(Bz + (sa + fr) * SS_BP + (32 * ks + 4 * fq) * 2); fb[ks] = ld_perm(Bz + (sb + fr) * SS_BP + (32 * ks + 4 * fq) * 2); }
            f32x4 ga = (f32x4){0.f, 0.f, 0.f, 0.f}, gb = ga;
#pragma unroll
            for (int ks = 0; ks < 4; ++ks) { ga = __builtin_amdgcn_mfma_f32_16x16x32_bf16(fa[ks], cf[ks], ga, 0, 0, 0); gb = __builtin_amdgcn_mfma_f32_16x16x32_bf16(fb[ks], cf[ks], gb, 0, 0, 0); }
            const f32x4 aa = *(const LAS f32x4*)(acsS + sa + 4 * fq), da = *(const LAS f32x4*)(dtS + sa + 4 * fq), ab = *(const LAS f32x4*)(acsS + sb + 4 * fq), db = *(const LAS f32x4*)(dtS + sb + 4 * fq);
#pragma unroll
            for (int pb = 0; pb < 4; ++pb) { const s16x4 lo = __builtin_amdgcn_ds_read_tr16_b64_v4i16((LAS s16x4*)(Xz + (sa + trow) * SS_XP + 32 * pb + tcol)); const s16x4 hi = __builtin_amdgcn_ds_read_tr16_b64_v4i16((LAS s16x4*)(Xz + (sb + trow) * SS_XP + 32 * pb + tcol));
                xf[pb] = __builtin_shufflevector(lo, hi, 0, 1, 2, 3, 4, 5, 6, 7); }
#pragma unroll
            for (int rg = 0; rg < 4; ++rg) { const int s1 = sa + 4 * fq + rg, s2 = sa + 16 + 4 * fq + rg;
                ga[rg] = (s1 <= l) ? ga[rg] * __expf(acs_l - aa[rg]) * da[rg] : 0.f; gb[rg] = (hasb && s2 <= l) ? gb[rg] * __expf(acs_l - ab[rg]) * db[rg] : 0.f; }
            v4u mw; mw.x = pk2(ga[0], ga[1]); mw.y = pk2(ga[2], ga[3]); mw.z = pk2(gb[0], gb[1]); mw.w = pk2(gb[2], gb[3]);
            const bf16x8 mf = __builtin_bit_cast(bf16x8, mw);
#pragma unroll
            for (int pb = 0; pb < 4; ++pb) acc[pb] = __builtin_amdgcn_mfma_f32_16x16x32_bf16(xf[pb], mf, acc[pb], 0, 0, 0);
        }
        float ssq = 0.f; const size_t arow = ((size_t)b * 2048 + (size_t)c * 128 + l) * 4096 + h * 64 + 4 * fq;
        v2u xrv[4];
#pragma unroll
        for (int pb = 0; pb < 4; ++pb) xrv[pb] = *(const LAS v2u*)(Xr + l * SS_XP + (16 * pb + 4 * fq) * 2);
#pragma unroll
        for (int pb = 0; pb < 4; ++pb) { const v2u xr = xrv[pb];
            const float y0 = (acc[pb][0] + bflo(xr.x) * dsk) * pg8::fast_silu(bflo(zv[pb].x)), y1 = (acc[pb][1] + bfhi(xr.x) * dsk) * pg8::fast_silu(bfhi(zv[pb].x));
            const float y2 = (acc[pb][2] + bflo(xr.y) * dsk) * pg8::fast_silu(bflo(zv[pb].y)), y3 = (acc[pb][3] + bfhi(xr.y) * dsk) * pg8::fast_silu(bfhi(zv[pb].y));
            ssq += (y0 * y0 + y1 * y1) + (y2 * y2 + y3 * y3);
            v2u o; o.x = pk2(y0, y1); o.y = pk2(y2, y3); *(v2u*)(A2 + arow + 16 * pb) = o; }
        ssq += __shfl_xor(ssq, 16); ssq += __shfl_xor(ssq, 32);
        if (fq == 0) SSQ[((size_t)b * 2048 + (size_t)c * 128 + l) * 32 + h] = ssq;
        if (c + 1 < 16) SSD_ZLOAD(c + 1);
        f32x4 sacc[4];
#pragma unroll
        for (int i = 0; i < 4; ++i) sacc[i] = (f32x4){0.f, 0.f, 0.f, 0.f};
        {
            bf16x8 uA[5], uB[5];
#define SSD_LDS_UP(dst, ks_) do { dst[4] = ld_tr2(Xw + (32 * (ks_) + trow) * SS_XP + 32 * (w >> 1) + tcol, 16 * SS_XP); _Pragma("unroll") for (int i = 0; i < 4; ++i) dst[i] = ld_tr2(Bm + (32 * (ks_) + trow) * SS_BP + 32 * (4 * (w & 1) + i) + tcol, 16 * SS_BP); } while (0)
#define SSD_MMA_UP(src) _Pragma("unroll") for (int i = 0; i < 4; ++i) sacc[i] = __builtin_amdgcn_mfma_f32_16x16x32_bf16(src[4], src[i], sacc[i], 0, 0, 0)
            SSD_LDS_UP(uA, 0); SSD_MMA_UP(uA); SSD_LDS_UP(uB, 1); SSD_MMA_UP(uB); SSD_LDS_UP(uA, 2); SSD_MMA_UP(uA); SSD_LDS_UP(uB, 3); SSD_MMA_UP(uB);
#undef SSD_LDS_UP
#undef SSD_MMA_UP
        }
#pragma unroll
        for (int i = 0; i < 4; ++i) S[i] = S[i] * eL + sacc[i];
    }
#undef SSD_LOAD
#undef SSD_ZLOAD
    __syncthreads();
}
constexpr int ATT_PITCH = 288;
constexpr int ATT_VOFF = 256 * ATT_PITCH;
template <int I0, int I1, bool FUSE>
__device__ __forceinline__ void attn_phase_mfma(Frame& F) {
    const bf16* Q = (const bf16*)(F.ws + WS_Q); const bf16* Kb = (const bf16*)(F.ws + WS_K); const bf16* Vb = (const bf16*)(F.ws + WS_V); float* LSE = (float*)(F.ws + WS_LSE);
    const int w = F.wave, lane = F.lane, fr = lane & 15, fq = lane >> 4, tid = F.tid;
    constexpr int SLOT = 128 * ATT_PITCH;
    for (int ci = blockIdx.x; ci < 256; ci += F.G) {
        const int bh = ci >> 1, half = ci & 1, b = bh >> 4, hd = bh & 15;
        v4u pk[4], pv[4]; bf16x8 qn[4];
#define ATT_UNIT(i, pt, r, n) do { if ((i) < 8) { pt = 0; r = 0; n = 8 * half + (i); } else if ((i) < 16) { pt = 1; r = 2 * half + (((i) - 8) >> 2); n = ((i) - 8) & 3; } else { pt = 2; r = 8 * half + ((i) - 16); n = 0; } } while (0)
#define ATT_LOADBLK(dil_, r_, nb_) do { _Pragma("unroll") for (int j = 0; j < 4; ++j) { const int c = tid + 512 * j, kj = c >> 4, ch = c & 15; const size_t off = (size_t)(b * 2048 + (dil_) * (128 * (nb_) + kj) + (r_)) * 2048 + hd * 128 + ch * 8; pk[j] = *(const v4u*)(Kb + off); pv[j] = *(const v4u*)(Vb + off); } } while (0)
#define ATT_STOREBLK(slot_) do { _Pragma("unroll") for (int j = 0; j < 4; ++j) { const int c = tid + 512 * j, kj = c >> 4, ch = c & 15; *(LAS v4u*)(F.lds + (slot_) * SLOT + kj * ATT_PITCH + ch * 16) = pk[j]; *(LAS v4u*)(F.lds + ATT_VOFF + (slot_) * SLOT + kj * ATT_PITCH + ch * 16) = pv[j]; } } while (0)
#define ATT_ZEROBLK(slot_) do { _Pragma("unroll") for (int j = 0; j < 4; ++j) { const int c = tid + 512 * j, kj = c >> 4, ch = c & 15; *(LAS v4u*)(F.lds + (slot_) * SLOT + kj * ATT_PITCH + ch * 16) = (v4u){0u, 0u, 0u, 0u}; *(LAS v4u*)(F.lds + ATT_VOFF + (slot_) * SLOT + kj * ATT_PITCH + ch * 16) = (v4u){0u, 0u, 0u, 0u}; } } while (0)
        __syncthreads();
        { int pt, r, n; ATT_UNIT(I0, pt, r, n); const int dil0 = pt == 0 ? 1 : (pt == 1 ? 4 : 16);
          if (n > 0) { ATT_LOADBLK(dil0, r, n - 1); ATT_STOREBLK((n - 1) & 1); } else { ATT_ZEROBLK(1); }
          ATT_LOADBLK(dil0, r, n); ATT_STOREBLK(n & 1);
          const size_t q0row = (size_t)(b * 2048 + dil0 * (128 * n + 16 * w + fr) + r);
#pragma unroll
          for (int ks = 0; ks < 4; ++ks) qn[ks] = *(const bf16x8*)(Q + q0row * 2048 + hd * 128 + 32 * ks + 8 * fq); }
        for (int i = I0; i < I1; ++i) {
            int pt, r, n; ATT_UNIT(i, pt, r, n);
            const int dil = pt == 0 ? 1 : (pt == 1 ? 4 : 16);
            bf16* Op = (bf16*)(F.ws + (pt == 0 ? WS_O1 : WS_O2));
            const int qi = 16 * w + fr; const size_t qrow = (size_t)(b * 2048 + dil * (128 * n + qi) + r);
            bf16x8 qf[4];
#pragma unroll
            for (int ks = 0; ks < 4; ++ks) qf[ks] = qn[ks];
            int npt = 0, nr = 0, nn = 0;
            if (i + 1 < I1) { ATT_UNIT(i + 1, npt, nr, nn); const int ndil = npt == 0 ? 1 : (npt == 1 ? 4 : 16); ATT_LOADBLK(ndil, nr, nn);
                const size_t nqrow = (size_t)(b * 2048 + ndil * (128 * nn + qi) + nr);
#pragma unroll
                for (int ks = 0; ks < 4; ++ks) qn[ks] = *(const bf16x8*)(Q + nqrow * 2048 + hd * 128 + 32 * ks + 8 * fq); }
            WG_SYNC_LDS();
            const int sprev = (n + 1) & 1, scur = n & 1;
            f32x4 s[9];
#define ATT_QK(kbi_) do { const int kb = w + (kbi_); const LAS unsigned char* kt = F.lds + (kb < 8 ? sprev : scur) * SLOT + (16 * (kb & 7) + fr) * ATT_PITCH + fq * 16; bf16x8 ka[4]; \
                _Pragma("unroll") for (int ks = 0; ks < 4; ++ks) ka[ks] = *(const LAS bf16x8*)(kt + ks * 64); \
                _Pragma("unroll") for (int ks = 0; ks < 4; ++ks) s[kbi_] = __builtin_amdgcn_mfma_f32_16x16x32_bf16(ka[ks], qf[ks], s[kbi_], 0, 0, 0); } while (0)
#pragma unroll
            for (int kbi = 0; kbi < 9; ++kbi) s[kbi] = (f32x4){0.f, 0.f, 0.f, 0.f};
            if (n > 0) {
#pragma unroll
                for (int kbi = 0; kbi < 9; ++kbi) ATT_QK(kbi);
            } else {
#pragma unroll
                for (int kbi = 0; kbi < 9; ++kbi) if (w + kbi >= 8) ATT_QK(kbi);
            }
#undef ATT_QK
            float mx = -1.0e30f;
#pragma unroll
            for (int kbi = 0; kbi < 9; ++kbi) { const bool blk = (n > 0) || (w + kbi >= 8);
#pragma unroll
                for (int rg = 0; rg < 4; ++rg) { const bool ok = blk && (kbi == 0 ? (4 * fq + rg >= fr) : (kbi == 8 ? (4 * fq + rg <= fr) : true));
                    s[kbi][rg] = ok ? s[kbi][rg] : -1.0e30f; mx = fmaxf(mx, s[kbi][rg]); } }
            mx = fmaxf(mx, __shfl_xor(mx, 16)); mx = fmaxf(mx, __shfl_xor(mx, 32));
            float lsum = 0.f;
#pragma unroll
            for (int kbi = 0; kbi < 9; ++kbi)
#pragma unroll
                for (int rg = 0; rg < 4; ++rg) { const float pvv = __builtin_amdgcn_exp2f(s[kbi][rg] - mx); s[kbi][rg] = pvv; lsum += pvv; }
            lsum += __shfl_xor(lsum, 16); lsum += __shfl_xor(lsum, 32);
            v2u oa[8], oc[8]; float l1 = 0.f, l2 = 0.f;
            if (FUSE) { const bf16* O1 = (const bf16*)(F.ws + WS_O1); const bf16* O2 = (const bf16*)(F.ws + WS_O2);
                l1 = LSE[((size_t)0 * M + qrow) * 16 + hd]; l2 = LSE[((size_t)1 * M + qrow) * 16 + hd];
#pragma unroll
                for (int db = 0; db < 8; ++db) { const size_t oo = qrow * 2048 + hd * 128 + 16 * db + 4 * fq; oa[db] = *(const v2u*)(O1 + oo); oc[db] = *(const v2u*)(O2 + oo); } }
            f32x4 o[8];
#pragma unroll
            for (int db = 0; db < 8; ++db) o[db] = (f32x4){0.f, 0.f, 0.f, 0.f};
            const int trow = 4 * fq + ((lane & 15) >> 2), tcol = (lane & 3) * 8;
#define ATT_PV(kk_) do { const int kba = w + 2 * (kk_), kbb = ((kk_) < 4) ? kba + 1 : kba; \
                v4u pw; pw.x = pk2(s[2 * (kk_)][0], s[2 * (kk_)][1]); pw.y = pk2(s[2 * (kk_)][2], s[2 * (kk_)][3]); \
                if ((kk_) < 4) { pw.z = pk2(s[((kk_) < 4 ? 2 * (kk_) + 1 : 8)][0], s[((kk_) < 4 ? 2 * (kk_) + 1 : 8)][1]); pw.w = pk2(s[((kk_) < 4 ? 2 * (kk_) + 1 : 8)][2], s[((kk_) < 4 ? 2 * (kk_) + 1 : 8)][3]); } else { pw.z = 0u; pw.w = 0u; } \
                const bf16x8 pf = __builtin_bit_cast(bf16x8, pw); \
                const LAS unsigned char* va = F.lds + ATT_VOFF + (kba < 8 ? sprev : scur) * SLOT + (16 * (kba & 7) + trow) * ATT_PITCH + tcol; \
                const LAS unsigned char* vb = F.lds + ATT_VOFF + (kbb < 8 ? sprev : scur) * SLOT + (16 * (kbb & 7) + trow) * ATT_PITCH + tcol; \
                s16x4 lo[8], hi[8];                                                  \
                _Pragma("unroll") for (int db = 0; db < 8; ++db) { lo[db] = __builtin_amdgcn_ds_read_tr16_b64_v4i16((LAS s16x4*)(va + 32 * db)); hi[db] = __builtin_amdgcn_ds_read_tr16_b64_v4i16((LAS s16x4*)(vb + 32 * db)); } \
                _Pragma("unroll") for (int db = 0; db < 8; ++db) { const bf16x8 vf = __builtin_shufflevector(lo[db], hi[db], 0, 1, 2, 3, 4, 5, 6, 7); o[db] = __builtin_amdgcn_mfma_f32_16x16x32_bf16(vf, pf, o[db], 0, 0, 0); } } while (0)
            if (n > 0) {
#pragma unroll
                for (int kk = 0; kk < 5; ++kk) ATT_PV(kk);
            } else {
#pragma unroll
                for (int kk = 0; kk < 5; ++kk) { const int kba = w + 2 * kk, kbb = (kk < 4) ? kba + 1 : kba; if (kbb >= 8 || kba >= 8) ATT_PV(kk); }
            }
#undef ATT_PV
            const float inv = 1.0f / lsum;
            if (!FUSE) {
#pragma unroll
                for (int db = 0; db < 8; ++db) { v2u wv; wv.x = pk2(o[db][0] * inv, o[db][1] * inv); wv.y = pk2(o[db][2] * inv, o[db][3] * inv); *(v2u*)(Op + qrow * 2048 + hd * 128 + 16 * db + 4 * fq) = wv; }
                if (fq == 0) LSE[((size_t)pt * M + qrow) * 16 + hd] = mx + __builtin_amdgcn_logf(lsum);
            } else {
                const float l3 = mx + __builtin_amdgcn_logf(lsum);
                const float mm = fmaxf(l1, fmaxf(l2, l3)); const float w1r = __builtin_amdgcn_exp2f(l1 - mm), w2r = __builtin_amdgcn_exp2f(l2 - mm), w3r = __builtin_amdgcn_exp2f(l3 - mm); const float iw = 1.0f / (w1r + w2r + w3r);
                const float w1 = w1r * iw, w2 = w2r * iw, w3 = w3r * iw * inv;
                bf16* A2 = (bf16*)(F.ws + WS_A2H);
#pragma unroll
                for (int db = 0; db < 8; ++db) { const v2u a = oa[db], c = oc[db];
                    v2u wv; wv.x = pk2(w1 * bflo(a.x) + w2 * bflo(c.x) + w3 * o[db][0], w1 * bfhi(a.x) + w2 * bfhi(c.x) + w3 * o[db][1]); wv.y = pk2(w1 * bflo(a.y) + w2 * bflo(c.y) + w3 * o[db][2], w1 * bfhi(a.y) + w2 * bfhi(c.y) + w3 * o[db][3]);
                    *(v2u*)(A2 + qrow * 4096 + 2048 + hd * 128 + 16 * db + 4 * fq) = wv; }
            }
            WG_SYNC_LDS();
            if (i + 1 < I1) { ATT_STOREBLK(nn & 1); if (nn == 0) { ATT_ZEROBLK(1); } }
        }
#undef ATT_UNIT
#undef ATT_LOADBLK
#undef ATT_STOREBLK
#undef ATT_ZEROBLK
    }
    __syncthreads();
}
constexpr int SP_WPITCH = 272, SP_VPITCH = 288, SP_VOFF = 128 * SP_WPITCH;
__device__ __forceinline__ void spatial_mfma(Frame& F, const float* wsp, const float* bsp, const float* ln_g, const float* ln_b) {
    const bf16* UV = (const bf16*)(F.ws + WS_UV); bf16* A2 = (bf16*)(F.ws + WS_A2S); const float* VST = (const float*)(F.ws + WS_VSTAT);
    LAS unsigned char* Wt = F.lds; LAS unsigned char* Vt = F.lds + SP_VOFF; LAS float* muS = (LAS float*)(F.lds + SP_VOFF + 128 * SP_VPITCH);
    LAS float* rsS = muS + 256; LAS unsigned char* Ut = F.lds + SP_VOFF + 128 * SP_VPITCH + 2048;
    const int w = F.wave, lane = F.lane, fr = lane & 15, fq = lane >> 4, tid = F.tid;
    const int trow = 4 * fq + ((lane & 15) >> 2), tcol = (lane & 3) * 8;
    const int nun = (8 * 16 * 8 - (int)blockIdx.x + F.G - 1) / F.G;
    if (nun <= 0) return;
    int gcur = -1;
    v4u pvA[4], pvB[4]; v4u puA[4], puB[4]; f32x4 pgA[4], pgB[4]; f32x4 st[8];
#define SP_PREFETCH(it_, PV_, PU_, PG_) do { const int u_ = (int)blockIdx.x + ((it_) >> 2) * F.G, g_ = u_ & 7, dq_ = (it_) & 3; const size_t r0_ = (size_t)(u_ >> 3) * 128; \
        _Pragma("unroll") for (int j = 0; j < 4; ++j) { const int c = tid + 512 * j, sr = c >> 4, ch = c & 15; PV_[j] = *(const v4u*)(UV + (r0_ + sr) * UV_LD + 4096 + g_ * 512 + dq_ * 128 + ch * 8); } \
        { const int dc = g_ * 512 + dq_ * 128 + (tid & 15) * 8; PG_[0] = *(const f32x4*)(ln_g + dc); PG_[1] = *(const f32x4*)(ln_g + dc + 4); PG_[2] = *(const f32x4*)(ln_b + dc); PG_[3] = *(const f32x4*)(ln_b + dc + 4); } \
        _Pragma("unroll") for (int j = 0; j < 4; ++j) { const int c = tid + 512 * j, sr = c >> 4, ch = c & 15; PU_[j] = *(const v4u*)(UV + (r0_ + sr) * UV_LD + g_ * 512 + dq_ * 128 + ch * 8); } } while (0)
#define SP_STATLOAD(un_) do { const int u_ = (int)blockIdx.x + (un_) * F.G; const f32x4* sp = (const f32x4*)(VST + ((size_t)(u_ >> 3) * 128 + (tid >> 2)) * 128) + (tid & 3) * 8; \
        _Pragma("unroll") for (int j = 0; j < 8; ++j) st[j] = sp[j]; } while (0)
#define SP_STATFIN(buf_) do { float s1 = 0.f, s2 = 0.f; _Pragma("unroll") for (int j = 0; j < 8; ++j) { s1 += st[j][0] + st[j][2]; s2 += st[j][1] + st[j][3]; } \
        s1 += __shfl_xor(s1, 1); s1 += __shfl_xor(s1, 2); s2 += __shfl_xor(s2, 1); s2 += __shfl_xor(s2, 2); \
        if ((tid & 3) == 0) { const float mu = s1 * (1.0f / 4096.0f), var = fmaxf(s2 * (1.0f / 4096.0f) - mu * mu, 0.f); muS[(buf_) * 128 + (tid >> 2)] = mu; rsS[(buf_) * 128 + (tid >> 2)] = rsqrtf(var + NORM_EPS); } } while (0)
    const int nit = nun * 4;
    __syncthreads();
    SP_STATLOAD(0); SP_STATFIN(0); SP_PREFETCH(0, pvA, puA, pgA); if (nit > 1) SP_PREFETCH(1, pvB, puB, pgB);
    float bias[8];
#define SP_ITER(it, PV_, PU_, PG_) do { \
        const int ui = (it) >> 2, dq = (it) & 3, u = (int)blockIdx.x + ui * F.G, g = u & 7; const size_t row0 = (size_t)(u >> 3) * 128; \
        WG_SYNC_LDS(); \
        if (g != gcur) { gcur = g; \
            for (int e = tid; e < 128 * 16; e += NWAVES * 64) { const int t = e >> 4, ch = e & 15; const f32x4 a = *(const f32x4*)(wsp + (size_t)g * 16384 + t * 128 + ch * 8), c = *(const f32x4*)(wsp + (size_t)g * 16384 + t * 128 + ch * 8 + 4); \
                const int s0 = ch * 8; v4u o; o.x = pk2(s0 + 0 <= t ? a[0] : 0.f, s0 + 1 <= t ? a[1] : 0.f); o.y = pk2(s0 + 2 <= t ? a[2] : 0.f, s0 + 3 <= t ? a[3] : 0.f); \
                o.z = pk2(s0 + 4 <= t ? c[0] : 0.f, s0 + 5 <= t ? c[1] : 0.f); o.w = pk2(s0 + 6 <= t ? c[2] : 0.f, s0 + 7 <= t ? c[3] : 0.f); \
                *(LAS v4u*)(Wt + t * SP_WPITCH + ch * 16) = o; } \
            _Pragma("unroll") for (int tb = 0; tb < 8; ++tb) bias[tb] = bsp[g * 128 + 16 * tb + fr]; } \
        const int sb = ui & 1; \
        _Pragma("unroll") for (int j = 0; j < 4; ++j) { const int c = tid + 512 * j, sr = c >> 4, ch = c & 15; const v4u v = PV_[j]; const float mu = muS[sb * 128 + sr], rs = rsS[sb * 128 + sr]; \
            v4u o; o.x = pk2((bflo(v.x) - mu) * rs * PG_[0][0] + PG_[2][0], (bfhi(v.x) - mu) * rs * PG_[0][1] + PG_[2][1]); o.y = pk2((bflo(v.y) - mu) * rs * PG_[0][2] + PG_[2][2], (bfhi(v.y) - mu) * rs * PG_[0][3] + PG_[2][3]); \
            o.z = pk2((bflo(v.z) - mu) * rs * PG_[1][0] + PG_[3][0], (bfhi(v.z) - mu) * rs * PG_[1][1] + PG_[3][1]); o.w = pk2((bflo(v.w) - mu) * rs * PG_[1][2] + PG_[3][2], (bfhi(v.w) - mu) * rs * PG_[1][3] + PG_[3][3]); \
            *(LAS v4u*)(Vt + sr * SP_VPITCH + ch * 16) = o; } \
        _Pragma("unroll") for (int j = 0; j < 4; ++j) { const int c = tid + 512 * j, sr = c >> 4, ch = c & 15; *(LAS v4u*)(Ut + sr * SP_VPITCH + ch * 16) = PU_[j]; } \
        const bool newunit = (dq == 3) && (ui + 1 < nun); \
        if (newunit) SP_STATLOAD(ui + 1); \
        if ((it) + 2 < nit) SP_PREFETCH((it) + 2, PV_, PU_, PG_); \
        WG_SYNC_LDS(); \
        bf16x8 vf[4]; \
        _Pragma("unroll") for (int ks = 0; ks < 4; ++ks) { const s16x4 lo = __builtin_amdgcn_ds_read_tr16_b64_v4i16((LAS s16x4*)(Vt + (32 * ks + trow) * SP_VPITCH + 32 * w + tcol)); const s16x4 hi = __builtin_amdgcn_ds_read_tr16_b64_v4i16((LAS s16x4*)(Vt + (32 * ks + 16 + trow) * SP_VPITCH + 32 * w + tcol)); \
            vf[ks] = __builtin_shufflevector(lo, hi, 0, 1, 2, 3, 4, 5, 6, 7); } \
        _Pragma("unroll") for (int tb = 0; tb < 8; ++tb) { f32x4 acc = (f32x4){0.f, 0.f, 0.f, 0.f}; \
            _Pragma("unroll") for (int ks = 0; ks < 4; ++ks) if (ks <= tb / 2) { const LAS unsigned char* wp = Wt + (16 * tb + fr) * SP_WPITCH + (32 * ks + 4 * fq) * 2; const v2u lo = *(const LAS v2u*)wp, hi = *(const LAS v2u*)(wp + 32); \
                const bf16x8 wf = __builtin_bit_cast(bf16x8, (v4u){lo.x, lo.y, hi.x, hi.y}); acc = __builtin_amdgcn_mfma_f32_16x16x32_bf16(vf[ks], wf, acc, 0, 0, 0); } \
            LAS v2u* up = (LAS v2u*)(Ut + (16 * tb + fr) * SP_VPITCH + (16 * w + 4 * fq) * 2); const v2u uu = *up; \
            const float bb = bias[tb]; v2u o; o.x = pk2(bflo(uu.x) * (acc[0] + bb), bfhi(uu.x) * (acc[1] + bb)); o.y = pk2(bflo(uu.y) * (acc[2] + bb), bfhi(uu.y) * (acc[3] + bb)); \
            *up = o; } \
        if (newunit) SP_STATFIN((ui + 1) & 1); \
        WG_SYNC_LDS(); \
        _Pragma("unroll") for (int j = 0; j < 4; ++j) { const int c = tid + 512 * j, sr = c >> 4, ch = c & 15; *(v4u*)(A2 + (row0 + sr) * 4096 + g * 512 + dq * 128 + ch * 8) = *(const LAS v4u*)(Ut + sr * SP_VPITCH + ch * 16); } } while (0)
    for (int it2 = 0; it2 < nit; it2 += 2) { SP_ITER(it2, pvA, puA, pgA); if (it2 + 1 < nit) SP_ITER(it2 + 1, pvB, puB, pgB); }
#undef SP_ITER
#undef SP_PREFETCH
#undef SP_STATLOAD
#undef SP_STATFIN
    __syncthreads();
}
template <int NN_> struct StaticOrderT { int G, c;
    __device__ __forceinline__ bool next(int i, pg8::Unit& u) const { constexpr int nM = M / 256, nN = NN_, nwg = nM * nN, NX = pg8::NXCD, WG = pg8::WGM; static_assert(nwg % NX == 0 && nM % WG == 0, "whole groups");
        const int L = i * G + c; if (L >= nwg) return false; const int wgid = (L % NX) * (nwg / NX) + L / NX; constexpr int nig = WG * nN; const int gid = wgid / nig, rem = wgid % nig; u.pm = gid * WG + rem % WG; u.pn = rem / WG; return true; }
    __device__ __forceinline__ void a_ready(const pg8::Unit&) const {}
    __device__ __forceinline__ void done(const pg8::Unit&) const {} };
template <class Epi, int NN_> __device__ __forceinline__ void run_gemm(Frame& F, const void* A, const void* Bt, int Kk, const Epi& E) {
    pg8::Gemm g{(const pg8::bf16_t*)A, (const pg8::bf16_t*)Bt, M, NN_ * 256, Kk}; StaticOrderT<NN_> S; S.G = F.G; S.c = (int)blockIdx.x;
    pg8::gemm_phase<Epi, StaticOrderT<NN_>, true, true>(F.lds + RING_OFF, g, S, E); }
struct Args { const float* in[25]; float* out; unsigned char* ws; int ph_lo, ph_hi, li, pad; };
__global__ void __launch_bounds__(NWAVES * 64, 2) trunk_fwd(Args args) {
    extern __shared__ __attribute__((aligned(16))) unsigned char lds[];
    Frame F;
    F.lds = (LAS unsigned char*)lds;
    F.MISC = (volatile LAS unsigned*)(F.lds + MISC_OFF);
    F.tid = threadIdx.x; F.lane = F.tid & 63; F.wave = __builtin_amdgcn_readfirstlane(F.tid >> 6);
    F.G = gridDim.x; { const int bx = blockIdx.x; F.vcu = (F.G % 8 == 0) ? (bx % 8) * (F.G / 8) + bx / 8 : bx; }
    F.ws = args.ws; F.ctl = (gu32*)(args.ws + WS_CTL);
    for (int u = F.tid; u < (LDS_BYTES - LDSCTL_OFF) / 4; u += NWAVES * 64) ((LAS unsigned*)(F.lds + LDSCTL_OFF))[u] = 0u;
    __syncthreads();
    XcdBarrier bar; bar.bar = (unsigned*)(F.ctl + CW_BAR); bar.x = 0; bar.st = nullptr;
    if (N_LAUNCHES == 1) bar = xcd_barrier_post((unsigned*)(F.ctl + CW_BAR), F.MISC + 8);
    const int lo = args.ph_lo, hi = args.ph_hi;
#define IN(k) (lo <= (k) && (k) < hi)
#define SEAM(k) do { if (IN(k) && IN((k) + 1)) { if ((k) < DEF_SEAMS) xcd_barrier_h(bar, [&]() { if (defer && F.wave >= 1) deferred_item(F, in, ((k) * 256 + F.vcu) * 7 + F.wave - 1); }); else xcd_barrier(bar); } } while (0)
    const float* const* in = args.in;
    const bool defer = defer_on(F);
    unsigned char* ws = args.ws;
    float* SHIFT = (float*)(ws + WS_MODV); float* APRE = SHIFT + MODV_N; float* APOST = APRE + MODV_N;
    bf16* Hb = (bf16*)(ws + WS_H); bf16* Fb = (bf16*)(ws + WS_F); bf16* HID = (bf16*)(ws + WS_HID);
    const float* x_in = in[0]; float* xo = args.out; bf16* XB = (bf16*)(ws + WS_XB);
#define MV(l, sub) ((size_t)((l) * 3 + (sub)) * 8 * 2048)
    typedef pg8::StaticOrder SO;
#define GEMM_PHASE(EPI, Aptr, Bptr, Nn, Kk, Eobj) run_gemm<EPI, (Nn) / 256>(F, (Aptr), (Bptr), (Kk), (Eobj))
#define FFN_PHASES(P, f) \
    if (IN(P)) { pg8::EpiSwiGLU E_{HID, FF}; GEMM_PHASE(pg8::EpiSwiGLU, Hb, ws + WS_WGU + (size_t)(f) * WGU_SZ, 2 * FF, D, E_); } SEAM(P); \
    if (IN((P) + 1)) { pg8::EpiPlain E_{Fb, D}; GEMM_PHASE(pg8::EpiPlain, HID, ws + WS_WDN + (size_t)(f) * WDN_SZ, D, FF, E_); } SEAM((P) + 1);

    if (IN(0)) p0_prologue(F, in);
    SEAM(0);
    if (IN(1)) rowpass<false, true, false, false>(F, x_in, nullptr, nullptr, nullptr, APRE + MV(0, 0), SHIFT + MV(0, 0), Hb);
    SEAM(1);
    FFN_PHASES(2, 0)
    if (IN(4)) rowpass<true, true, false, true>(F, x_in, XB, Fb, APOST + MV(0, 0), APRE + MV(0, 1), SHIFT + MV(0, 1), Hb);
    SEAM(4);
    if (IN(5)) { pg8::EpiHyb E_{ws + WS_BIG, (const int*)in[2], QSCALE};
        GEMM_PHASE(pg8::EpiHyb, Hb, ws + WS_WHIN, HYB_N - 256, D, E_); dt_minigemm(F, Hb, (const bf16*)(ws + WS_WHIN) + (size_t)44 * 256 * 2048, (float*)(ws + WS_DT)); }
    SEAM(5);
    if (IN(6)) { ssd_prepass(F, in); attn_phase_mfma<0, 16, false>(F); }
    SEAM(6);
    if (IN(7)) { for (int u = blockIdx.x; u < 256; u += F.G) ssd_unit_mfma(F, u >> 5, u & 31, in); attn_phase_mfma<16, 24, true>(F); }
    SEAM(7);
    if (IN(8)) {
        LAS float* rsT = (LAS float*)(F.lds + RING_BYTES); const float* SSQ = (const float*)(ws + WS_SSQ);
        { const int nN_ = D / 256, nwg_ = (M / 256) * nN_;
          for (int i = 0; i < 16; ++i) { const int L_ = i * F.G + (int)blockIdx.x; if (L_ >= nwg_) break; const int wg_ = (L_ % 8) * (nwg_ / 8) + L_ / 8; const int pm_ = (wg_ / (8 * nN_)) * 8 + (wg_ % (8 * nN_)) % 8;
            if (F.tid < 256) { const f32x4* sp = (const f32x4*)(SSQ + (size_t)(pm_ * 256 + F.tid) * 32); float sm = 0.f;
#pragma unroll
              for (int j = 0; j < 8; ++j) { const f32x4 q = sp[j]; sm += (q[0] + q[1]) + (q[2] + q[3]); }
              rsT[i * 256 + F.tid] = rsqrtf(sm * (1.0f / 2048.0f) + NORM_EPS); } } }
        __syncthreads();
        pg8::EpiPlainMid E_{Fb, D, rsT}; GEMM_PHASE(pg8::EpiPlainMid, ws + WS_A2H, ws + WS_WHOUT, D, 4096, E_); }
    SEAM(8);
    if (IN(9)) rowpass<true, true, true, true>(F, XB, XB, Fb, APOST + MV(0, 1), APRE + MV(0, 2), SHIFT + MV(0, 2), Hb);
    SEAM(9);
    FFN_PHASES(10, 1)
    if (IN(12)) rowpass<true, true, true, true>(F, XB, XB, Fb, APOST + MV(0, 2), APRE + MV(1, 0), SHIFT + MV(1, 0), Hb);
    SEAM(12);
    FFN_PHASES(13, 2)
    if (IN(15)) rowpass<true, true, true, true>(F, XB, XB, Fb, APOST + MV(1, 0), APRE + MV(1, 1), SHIFT + MV(1, 1), Hb);
    SEAM(15);
    if (IN(16)) { pg8::EpiGelu E_{(bf16*)(ws + WS_UV), UV_LD, in[19], (float*)(ws + WS_VSTAT), 16}; GEMM_PHASE(pg8::EpiGelu, Hb, ws + WS_WSIN, 8192, D, E_); }
    SEAM(16);
    if (IN(17)) spatial_mfma(F, in[22], in[23], in[20], in[21]);
    SEAM(17);
    if (IN(18)) { pg8::EpiPlain E_{Fb, D}; GEMM_PHASE(pg8::EpiPlain, ws + WS_A2S, ws + WS_WSOUT, D, 4096, E_); }
    SEAM(18);
    if (IN(19)) rowpass<true, true, true, true>(F, XB, XB, Fb, APOST + MV(1, 1), APRE + MV(1, 2), SHIFT + MV(1, 2), Hb);
    SEAM(19);
    FFN_PHASES(20, 3)
    if (IN(22)) rowpass<true, false, true, false>(F, XB, xo, Fb, APOST + MV(1, 2), nullptr, nullptr, nullptr);
#undef IN
#undef SEAM
}

extern "C" void kernel_launch(void* const* d_in, const int* in_sizes, int n_in, void* d_out, int out_size, void* d_ws, size_t ws_size, hipStream_t stream) {
    static int grid = 0;
    if (grid == 0) {
        if (n_in != 25 || in_sizes[0] != M * D || out_size != M * D || ws_size < WS_END) { fprintf(stderr, "kernel_launch: unexpected shapes (n_in %d, in0 %d, out %d, ws %zu < %zu); nothing launched\n", n_in, n_in > 0 ? in_sizes[0] : -1, out_size, ws_size, (size_t)WS_END); grid = -1; return; }
        int dev = 0, cus = 0, per_cu = 0;
        if (hipGetDevice(&dev) != hipSuccess || hipDeviceGetAttribute(&cus, hipDeviceAttributeMultiprocessorCount, dev) != hipSuccess) { grid = -1; return; }
        if (hipFuncSetAttribute((const void*)trunk_fwd, hipFuncAttributeMaxDynamicSharedMemorySize, LDS_BYTES) != hipSuccess) { fprintf(stderr, "kernel_launch: hipFuncSetAttribute failed\n"); grid = -1; return; }
        if (hipOccupancyMaxActiveBlocksPerMultiprocessor(&per_cu, (const void*)trunk_fwd, NWAVES * 64, LDS_BYTES) != hipSuccess || per_cu < 1) { fprintf(stderr, "kernel_launch: occupancy query reports %d blocks per CU\n", per_cu); }
        (void)hipGetLastError();
        grid = cus;
    }
    if (grid < 0) return;
    if (hipMemsetAsync((char*)d_ws + WS_CTL, 0, CTL_ZERO_BYTES, stream) != hipSuccess) return;
    Args a{};
    for (int i = 0; i < 25; ++i) a.in[i] = (const float*)d_in[i];
    a.out = (float*)d_out; a.ws = (unsigned char*)d_ws; a.pad = 0;
    for (int li = 0; li < N_LAUNCHES; ++li) {
        a.ph_lo = (N_LAUNCHES == 1) ? 0 : li; a.ph_hi = (N_LAUNCHES == 1) ? NPHASE : li + 1; a.li = li;
        hipLaunchKernelGGL(trunk_fwd, dim3(grid), dim3(NWAVES * 64), LDS_BYTES, stream, a);
    }
}
```
